# Optimizing an MI355X kernel written in HIP

```python
import jax
import jax.numpy as jnp
from jax import lax
import numpy as np

D_MODEL = 1024
BATCH = 16
SEQ = 2048
DEPTH = 4

GRID_W = 64
CTX_LEN = 256
D_FF = 4 * D_MODEL
N_EVEN = (DEPTH + 1) // 2
N_ODD = DEPTH // 2
MIX_W = D_MODEL

MLSTM_HEADS = 4
MLSTM_DH = MIX_W // 2 // MLSTM_HEADS
MLSTM_W = MLSTM_HEADS * MLSTM_DH
MLSTM_CHUNK = 64
RWKV_W = MIX_W // 2
RWKV_DH = 64
RWKV_HEADS = RWKV_W // RWKV_DH
RWKV_DECAY_RANK = 64
RWKV_ICLR_RANK = 64
RWKV_GATE_RANK = 128
RWKV_LN_EPS = 64e-5
LRU_W = MIX_W // 2
LRU_BLOCKS = 8
LRU_BW = LRU_W // LRU_BLOCKS
LRU_CONV = 4
LRU_CONV_PAD = ((LRU_CONV - 1) // 2, LRU_CONV // 2)
LRU_C = 8.0
NA_W = MIX_W // 2
NA_DH = 64
NA_HEADS = NA_W // NA_DH
NA_KH = 8
NA_KW = 16
NA_COL_BLOCK = 16
NA_COL_BAND = 32
ROPE_BASE = 10000.0
NORM_EPS = 1e-6

MLSTM_SPLITS = [MLSTM_W] * 4 + [2 * MLSTM_HEADS] * 2
MLSTM_IN = sum(MLSTM_SPLITS)
RWKV_SPLITS = [RWKV_W] * 3 + [2 * RWKV_DECAY_RANK, 2 * RWKV_ICLR_RANK, RWKV_GATE_RANK]
RWKV_IN = sum(RWKV_SPLITS)
EVEN_IN = MLSTM_IN + RWKV_IN
ODD_SPLITS = [LRU_W, LRU_W, NA_W, NA_W, NA_W]
ODD_IN = sum(ODD_SPLITS)

kernel_name = 'hybrid_mlstm_rwkv7_rglru_natten_prefix_dit'


def _cuts(sizes):
    return [int(v) for v in np.cumsum(sizes)[:-1]]


def rms_norm(x):
    xf = x.astype(jnp.float32)
    return (xf * lax.rsqrt(jnp.mean(xf * xf, axis=-1, keepdims=True) + NORM_EPS)).astype(x.dtype)


def ada_modulation(cond, w, b):
    m = jax.nn.silu(cond) @ w + b
    return jnp.split(m[:, None, :], 6, axis=-1)


def modulate(h, shift, scale):
    return h * (1 + scale) + shift


def sq_relu_mlp(h, w1, w2):
    return jnp.square(jax.nn.relu(h @ w1)) @ w2


def axial_rope(n_tok, head_dim, dtype):
    t = jnp.arange(n_tok)
    row = (t // GRID_W).astype(jnp.float32)
    col = (t % GRID_W).astype(jnp.float32)
    n_freq = head_dim // 4
    inv = ROPE_BASE ** (-jnp.arange(n_freq, dtype=jnp.float32) / n_freq)
    ang = jnp.concatenate([row[:, None] * inv, col[:, None] * inv], axis=-1)
    return jnp.cos(ang).astype(dtype), jnp.sin(ang).astype(dtype)


def apply_rope(x, cos, sin):
    x1, x2 = jnp.split(x, 2, axis=-1)
    cos = cos[None, :, None, :]
    sin = sin[None, :, None, :]
    return jnp.concatenate([x1 * cos - x2 * sin, x1 * sin + x2 * cos], axis=-1)


def centred_shift(z):
    zp = jnp.pad(z, ((0, 0), (1, 1), (0, 0)))
    return 0.5 * (zp[:, :-2] + zp[:, 2:])


def mlstm_inputs(z, gate_b, rope):
    B, T, _ = z.shape
    q, k, v, og, ig, fg = jnp.split(z, _cuts(MLSTM_SPLITS), axis=-1)
    heads = lambda a: a.reshape(B, T, MLSTM_HEADS, MLSTM_DH)
    q, k, v = heads(q), heads(k) * (MLSTM_DH ** -0.5), heads(v)
    if rope is not None:
        q = apply_rope(q, *rope)
        k = apply_rope(k, *rope)
    log_i = ig.reshape(B, T, 2, MLSTM_HEADS).astype(jnp.float32) + gate_b[:, 0]
    log_f = jax.nn.log_sigmoid(fg.reshape(B, T, 2, MLSTM_HEADS).astype(jnp.float32) + gate_b[:, 1])
    return q, k, v, log_i, log_f, og


def mlstm_run(q, k, v, log_i, log_f, state):
    B, T, H, dh = q.shape
    L = MLSTM_CHUNK
    nc = T // L
    both = lambda a: jnp.stack([a, jnp.flip(a, 1)], 0)
    per = lambda a: jnp.stack([a[:, :, 0], jnp.flip(a[:, :, 1], 1)], 0)

    def chunks(a):
        a = jnp.moveaxis(a, 2, 3)
        a = a.reshape(a.shape[:3] + (nc, L) + a.shape[4:])
        return jnp.moveaxis(a, 3, 0)

    lower = jnp.tril(jnp.ones((L, L), dtype=bool))

    def step(carry, inp):
        C, n, m = carry
        qc, kc, vc, li, lf = inp
        b = jnp.cumsum(lf, axis=-1)
        d = jnp.where(lower, b[..., :, None] - b[..., None, :] + li[..., None, :], -jnp.inf)
        m_prev = b + m[..., None]
        m_t = jnp.maximum(m_prev, jnp.max(d, axis=-1))
        w_prev = jnp.exp(m_prev - m_t)
        s = jnp.einsum('zbhtd,zbhsd->zbhts', qc, kc) * jnp.exp(d - m_t[..., None])
        num = w_prev[..., None] * jnp.einsum('zbhtd,zbhde->zbhte', qc, C) + jnp.einsum('zbhts,zbhse->zbhte', s, vc)
        den = w_prev * jnp.einsum('zbhtd,zbhd->zbht', qc, n) + jnp.sum(s, axis=-1)
        h = num / jnp.maximum(jnp.abs(den), jnp.exp(-m_t))[..., None]
        b_end = b[..., -1]
        g = b_end[..., None] - b + li
        m_new = jnp.maximum(b_end + m, jnp.max(g, axis=-1))
        keep = jnp.exp(b_end + m - m_new)
        wk = jnp.exp(g - m_new[..., None])
        C = keep[..., None, None] * C + jnp.einsum('zbhs,zbhsd,zbhse->zbhde', wk, kc, vc)
        n = keep[..., None] * n + jnp.einsum('zbhs,zbhsd->zbhd', wk, kc)
        return (C, n, m_new), h

    xs = (chunks(both(q)), chunks(both(k)), chunks(both(v)), chunks(per(log_i)), chunks(per(log_f)))
    state, h = lax.scan(step, state, xs)
    h = jnp.moveaxis(h, 0, 3).reshape(2, B, H, T, dh)
    h = jnp.moveaxis(h, 3, 2)
    return (h[0] + jnp.flip(h[1], 1)).astype(q.dtype), state


def mlstm_out(h, og, norm_w):
    B, T = og.shape[:2]
    hf = h.astype(jnp.float32)
    hn = (hf * lax.rsqrt(jnp.mean(hf * hf, axis=-1, keepdims=True) + NORM_EPS)).astype(og.dtype)
    hn = hn * norm_w.reshape(MLSTM_HEADS, MLSTM_DH)
    return hn.reshape(B, T, MLSTM_W) * jax.nn.sigmoid(og)


def rwkv_inputs(z, mu, w0, w_up, a0, a_up, g_up, k_k, k_a):
    B, T, _ = z.shape
    z = z + mu * (centred_shift(z) - z)
    r, k, v, wd, ad, gd = jnp.split(z, _cuts(RWKV_SPLITS), axis=-1)
    wd = wd.reshape(B, T, 2, RWKV_DECAY_RANK)
    ad = ad.reshape(B, T, 2, RWKV_ICLR_RANK)
    w_raw = (w0 + jnp.einsum('btzr,zrc->btzc', jnp.tanh(wd), w_up)).astype(jnp.float32)
    decay = jnp.exp(-jnp.exp(-jax.nn.softplus(-w_raw) - 0.5))
    a_lr = jax.nn.sigmoid((a0 + jnp.einsum('btzr,zrc->btzc', ad, a_up)).astype(jnp.float32))
    g = jax.nn.sigmoid(gd) @ g_up
    kkf = (k * k_k).astype(jnp.float32).reshape(B, T, RWKV_HEADS, RWKV_DH)
    kk = kkf / jnp.maximum(jnp.sqrt(jnp.sum(kkf * kkf, axis=-1, keepdims=True)), 1e-12)
    kk = kk.reshape(B, T, RWKV_W)
    k_dir = k[:, :, None, :] * (1 + (a_lr - 1) * k_a)
    b_vec = kk[:, :, None, :] * a_lr
    return r, k, v, decay, kk, k_dir, b_vec, g


def rwkv_run(r, v, decay, kk, k_dir, b_vec, S0):
    B, T = r.shape[:2]
    heads = lambda a: a.reshape(B, T, RWKV_HEADS, RWKV_DH)
    both = lambda a: jnp.moveaxis(jnp.stack([heads(a), jnp.flip(heads(a), 1)], 0), 2, 0)
    per = lambda a: jnp.moveaxis(jnp.stack([heads(a[:, :, 0]), jnp.flip(heads(a[:, :, 1]), 1)], 0), 2, 0)
    xs = (both(r), per(decay), per(k_dir), both(v), both(-kk), per(b_vec))

    def step(S, inp):
        r_t, w_t, k_t, v_t, a_t, b_t = inp
        sa = jnp.einsum('zbhij,zbhj->zbhi', S, a_t)
        S = S * w_t[..., None, :] + sa[..., :, None] * b_t[..., None, :] + v_t[..., :, None] * k_t[..., None, :]
        return S, jnp.einsum('zbhij,zbhj->zbhi', S, r_t)

    S, y = lax.scan(step, S0, xs)
    y = y[:, 0] + jnp.flip(y[:, 1], 0)
    return jnp.moveaxis(y, 0, 1), S


def rwkv_out(y, r, k, v, g, r_k, ln_w, ln_b):
    B, T = r.shape[:2]
    heads = lambda a: a.reshape(B, T, RWKV_HEADS, RWKV_DH)
    yf = y.astype(jnp.float32)
    mean = jnp.mean(yf, axis=-1, keepdims=True)
    var = jnp.mean(jnp.square(yf - mean), axis=-1, keepdims=True)
    yn = ((yf - mean) * lax.rsqrt(var + RWKV_LN_EPS)).astype(r.dtype)
    yn = yn * ln_w.reshape(RWKV_HEADS, RWKV_DH) + ln_b.reshape(RWKV_HEADS, RWKV_DH)
    bonus = jnp.sum(heads(r) * heads(k) * r_k, axis=-1, keepdims=True) * heads(v)
    return (yn + bonus).reshape(B, T, RWKV_W) * g


def _linear_combine(e1, e2):
    a1, b1 = e1
    a2, b2 = e2
    return a1 * a2, a2 * b1 + b2


def rglru(u_pre, gate_pre, conv_w, conv_b, gate_w, gate_b, lam, h0):
    B, T, W = u_pre.shape
    u = lax.conv_general_dilated(u_pre, conv_w[:, None, :], (1,), [LRU_CONV_PAD],
                                 dimension_numbers=('NWC', 'WIO', 'NWC'), feature_group_count=W) + conv_b
    gates = jnp.einsum('btnc,zgncd->btzgnd', u.reshape(B, T, LRU_BLOCKS, LRU_BW), gate_w).reshape(B, T, 2, 2, W)
    gates = jax.nn.sigmoid((gates + gate_b).astype(jnp.float32))
    rg, ig = gates[:, :, :, 0], gates[:, :, :, 1]
    log_a = -LRU_C * rg * jax.nn.softplus(-lam.astype(jnp.float32))
    a = jnp.exp(log_a)
    xin = jnp.sqrt(-jnp.expm1(2 * log_a)) * ig * u[:, :, None, :]
    per = lambda t: jnp.stack([t[:, :, 0], jnp.flip(t[:, :, 1], 1)], 0)
    a2, x2 = per(a), per(xin)
    x2 = x2.at[:, :, 0].add(a2[:, :, 0] * h0)
    _, h = lax.associative_scan(_linear_combine, (a2, x2), axis=2)
    y = h[0] + jnp.flip(h[1], 1)
    return y.astype(u_pre.dtype) * jax.nn.gelu(gate_pre), h[:, :, -1]


def _na_column_tables():
    n_cb = GRID_W // NA_COL_BLOCK
    qcol = np.arange(GRID_W).reshape(n_cb, NA_COL_BLOCK)
    band0 = np.clip(qcol[:, 0] - NA_KW // 2, 0, GRID_W - NA_COL_BAND)
    kcol = band0[:, None] + np.arange(NA_COL_BAND)
    win0 = np.clip(qcol - NA_KW // 2, 0, GRID_W - NA_KW)
    rel = kcol[:, None, :] - win0[:, :, None]
    in_win = (rel >= 0) & (rel < NA_KW)
    dcol = np.clip(kcol[:, None, :] - qcol[:, :, None] + NA_KW - 1, 0, 2 * NA_KW - 2)
    return kcol, in_win, dcol


def neighbourhood_attention(q, k, v, k_ctx, v_ctx, rpb):
    B, T, H, dh = q.shape
    rows = T // GRID_W
    kh = min(NA_KH, rows)
    n_cb = GRID_W // NA_COL_BLOCK
    kcol, in_win, dcol = _na_column_tables()
    in_win = jnp.asarray(in_win)[:, :, None, :]
    dcol = jnp.asarray(dcol)[None]
    qg = (q * dh ** -0.5).reshape(B, rows, GRID_W, H, dh)
    kg = k.reshape(B, rows, GRID_W, H, dh)
    vg = v.reshape(B, rows, GRID_W, H, dh)
    n_loc = kh * NA_COL_BAND

    def row_block(r):
        r0 = jnp.clip(r - kh // 2, 0, rows - kh)
        q_r = lax.dynamic_index_in_dim(qg, r, axis=1, keepdims=False).reshape(B, n_cb, NA_COL_BLOCK, H, dh)
        k_b = lax.dynamic_slice_in_dim(kg, r0, kh, axis=1)[:, :, kcol]
        v_b = lax.dynamic_slice_in_dim(vg, r0, kh, axis=1)[:, :, kcol]
        s_loc = jnp.einsum('bnqhd,bknjhd->bhnqkj', q_r, k_b).astype(jnp.float32)
        drow = (r0 + jnp.arange(kh) - r + NA_KH - 1)[:, None, None, None]
        bias = jnp.moveaxis(rpb[:, drow, dcol], 1, 3).astype(jnp.float32)
        s_loc = jnp.where(in_win, s_loc + bias, -jnp.inf)
        s_ctx = jnp.einsum('bnqhd,bmhd->bhnqm', q_r, k_ctx).astype(jnp.float32)
        s = jnp.concatenate([s_loc.reshape(B, H, n_cb, NA_COL_BLOCK, n_loc), s_ctx], axis=-1)
        p = jax.nn.softmax(s, axis=-1).astype(v.dtype)
        p_loc = p[..., :n_loc].reshape(B, H, n_cb, NA_COL_BLOCK, kh, NA_COL_BAND)
        o = jnp.einsum('bhnqkj,bknjhd->bnqhd', p_loc, v_b) + jnp.einsum('bhnqm,bmhd->bnqhd', p[..., n_loc:], v_ctx)
        return o.reshape(B, GRID_W, H * dh)

    out = lax.map(row_block, jnp.arange(rows))
    return jnp.moveaxis(out, 0, 1).reshape(B, T, H * dh)


def context_attention(q, k, v):
    B, Tc, H, dh = q.shape
    s = jnp.einsum('bqhd,bkhd->bhqk', q * dh ** -0.5, k).astype(jnp.float32)
    p = jax.nn.softmax(s, axis=-1).astype(v.dtype)
    return jnp.einsum('bhqk,bkhd->bqhd', p, v).reshape(B, Tc, H * dh)


def even_mixer(hx, hc, rope, ctx_out, in_w, out_w, gate_b, norm_w, mu, w0, w_up, a0, a_up, g_up, k_k, k_a,
               r_k, ln_w, ln_b):
    B = hx.shape[0]
    f32 = jnp.float32
    zx, zc = hx @ in_w, hc @ in_w
    mq_c, mk_c, mv_c, li_c, lf_c, og_c = mlstm_inputs(zc[..., :MLSTM_IN], gate_b, None)
    mq_x, mk_x, mv_x, li_x, lf_x, og_x = mlstm_inputs(zx[..., :MLSTM_IN], gate_b, rope)
    st0 = (jnp.zeros((2, B, MLSTM_HEADS, MLSTM_DH, MLSTM_DH), f32),
           jnp.zeros((2, B, MLSTM_HEADS, MLSTM_DH), f32),
           jnp.zeros((2, B, MLSTM_HEADS), f32))
    mh_c, st_c = mlstm_run(mq_c, mk_c, mv_c, li_c, lf_c, st0)
    mh_x, _ = mlstm_run(mq_x, mk_x, mv_x, li_x, lf_x, st_c)
    r_c, k_c, v_c, w_c, kk_c, kd_c, b_c, g_c = rwkv_inputs(zc[..., MLSTM_IN:], mu, w0, w_up, a0, a_up, g_up, k_k, k_a)
    r_x, k_x, v_x, w_x, kk_x, kd_x, b_x, g_x = rwkv_inputs(zx[..., MLSTM_IN:], mu, w0, w_up, a0, a_up, g_up, k_k, k_a)
    S0 = jnp.zeros((2, B, RWKV_HEADS, RWKV_DH, RWKV_DH), f32)
    ry_c, S_c = rwkv_run(r_c, v_c, w_c, kk_c, kd_c, b_c, S0)
    ry_x, _ = rwkv_run(r_x, v_x, w_x, kk_x, kd_x, b_x, S_c)
    ox = jnp.concatenate([mlstm_out(mh_x, og_x, norm_w),
                          rwkv_out(ry_x, r_x, k_x, v_x, g_x, r_k, ln_w, ln_b)], axis=-1) @ out_w
    if not ctx_out:
        return ox, None
    oc = jnp.concatenate([mlstm_out(mh_c, og_c, norm_w),
                          rwkv_out(ry_c, r_c, k_c, v_c, g_c, r_k, ln_w, ln_b)], axis=-1) @ out_w
    return ox, oc


def odd_mixer(hx, hc, ctx_out, in_w, out_w, conv_w, conv_b, gate_w, gate_b, lam, rpb):
    B = hx.shape[0]
    cuts = _cuts(ODD_SPLITS)
    ux, gx, qx, kx, vx = jnp.split(hx @ in_w, cuts, axis=-1)
    uc, gc, qc, kc, vc = jnp.split(hc @ in_w, cuts, axis=-1)
    yc, h_c = rglru(uc, gc, conv_w, conv_b, gate_w, gate_b, lam, jnp.zeros((2, B, LRU_W), jnp.float32))
    yx, _ = rglru(ux, gx, conv_w, conv_b, gate_w, gate_b, lam, h_c)
    heads = lambda a: a.reshape(a.shape[0], a.shape[1], NA_HEADS, NA_DH)
    ax = neighbourhood_attention(heads(qx), heads(kx), heads(vx), heads(kc), heads(vc), rpb)
    ox = jnp.concatenate([yx, ax], axis=-1) @ out_w
    if not ctx_out:
        return ox, None
    ac = context_attention(heads(qc), heads(kc), heads(vc))
    return ox, jnp.concatenate([yc, ac], axis=-1) @ out_w


def setup_inputs(seed: int = 0) -> dict:
    key = jax.random.key(seed)
    ks = iter(jax.random.split(key, 40))
    nrm = lambda shape, std: std * jax.random.normal(next(ks), shape, jnp.float32)
    D = D_MODEL
    x = nrm((BATCH, SEQ, D), 1.0)
    c = nrm((BATCH, D), 1.0)
    ctx = nrm((BATCH, CTX_LEN, D), 1.0)
    c_ctx = nrm((D,), 1.0)
    ada_w = nrm((DEPTH, D, 6 * D), 0.5 * D ** -0.5)
    ada_b = nrm((DEPTH, 6 * D), 0.02)
    mix_out_w = nrm((DEPTH, MIX_W, D), MIX_W ** -0.5)
    mlp_w1 = nrm((DEPTH, D, D_FF), D ** -0.5)
    mlp_w2 = nrm((DEPTH, D_FF, D), D_FF ** -0.5)
    ev_in_w = nrm((N_EVEN, D, EVEN_IN), D ** -0.5)
    f_bias = jnp.linspace(3.0, 6.0, MLSTM_HEADS, dtype=jnp.float32)
    ml_gate_b = jnp.stack([nrm((N_EVEN, 2, MLSTM_HEADS), 0.1),
                           f_bias + nrm((N_EVEN, 2, MLSTM_HEADS), 0.1)], axis=2)
    ml_norm_w = 1.0 + nrm((N_EVEN, MLSTM_W), 0.02)
    rw_mu = jax.random.uniform(next(ks), (N_EVEN, RWKV_IN), jnp.float32, 0.0, 1.0)
    rw_w0 = jnp.linspace(-6.5, -1.5, RWKV_W, dtype=jnp.float32) + nrm((N_EVEN, 2, RWKV_W), 0.1)
    rw_w_up = nrm((N_EVEN, 2, RWKV_DECAY_RANK, RWKV_W), 0.1 * RWKV_DECAY_RANK ** -0.5)
    rw_a0 = nrm((N_EVEN, 2, RWKV_W), 0.1)
    rw_a_up = nrm((N_EVEN, 2, RWKV_ICLR_RANK, RWKV_W), 0.1 * RWKV_ICLR_RANK ** -0.5)
    rw_g_up = nrm((N_EVEN, RWKV_GATE_RANK, RWKV_W), RWKV_GATE_RANK ** -0.5)
    rw_k_k = 0.85 + nrm((N_EVEN, RWKV_W), 0.02)
    rw_k_a = 1.0 + nrm((N_EVEN, RWKV_W), 0.02)
    rw_r_k = nrm((N_EVEN, RWKV_HEADS, RWKV_DH), 0.1)
    rw_ln_w = 1.0 + nrm((N_EVEN, RWKV_W), 0.02)
    rw_ln_b = nrm((N_EVEN, RWKV_W), 0.02)
    od_in_w = nrm((N_ODD, D, ODD_IN), D ** -0.5)
    lru_conv_w = nrm((N_ODD, LRU_CONV, LRU_W), LRU_CONV ** -0.5)
    lru_conv_b = nrm((N_ODD, LRU_W), 0.02)
    lru_gate_w = nrm((N_ODD, 2, 2, LRU_BLOCKS, LRU_BW, LRU_BW), LRU_BW ** -0.5)
    lru_gate_b = nrm((N_ODD, 2, 2, LRU_W), 0.02)
    a_c = jax.random.uniform(next(ks), (N_ODD, 2, LRU_W), jnp.float32, 0.9, 0.999)
    s = a_c ** (1.0 / LRU_C)
    lru_lambda = jnp.log(s) - jnp.log1p(-s)
    na_rpb = nrm((N_ODD, NA_HEADS, 2 * NA_KH - 1, 2 * NA_KW - 1), 0.1)
    final_norm_w = 1.0 + nrm((D,), 0.02)
    return {'x': x, 'c': c, 'ctx': ctx, 'c_ctx': c_ctx, 'ada_w': ada_w, 'ada_b': ada_b,
            'mix_out_w': mix_out_w, 'mlp_w1': mlp_w1, 'mlp_w2': mlp_w2, 'ev_in_w': ev_in_w,
            'ml_gate_b': ml_gate_b, 'ml_norm_w': ml_norm_w, 'rw_mu': rw_mu, 'rw_w0': rw_w0,
            'rw_w_up': rw_w_up, 'rw_a0': rw_a0, 'rw_a_up': rw_a_up, 'rw_g_up': rw_g_up,
            'rw_k_k': rw_k_k, 'rw_k_a': rw_k_a, 'rw_r_k': rw_r_k, 'rw_ln_w': rw_ln_w, 'rw_ln_b': rw_ln_b,
            'od_in_w': od_in_w, 'lru_conv_w': lru_conv_w, 'lru_conv_b': lru_conv_b,
            'lru_gate_w': lru_gate_w, 'lru_gate_b': lru_gate_b, 'lru_lambda': lru_lambda,
            'na_rpb': na_rpb, 'final_norm_w': final_norm_w}


def reference(x, c, ctx, c_ctx, ada_w, ada_b, mix_out_w, mlp_w1, mlp_w2, ev_in_w, ml_gate_b, ml_norm_w,
              rw_mu, rw_w0, rw_w_up, rw_a0, rw_a_up, rw_g_up, rw_k_k, rw_k_a, rw_r_k, rw_ln_w, rw_ln_b,
              od_in_w, lru_conv_w, lru_conv_b, lru_gate_w, lru_gate_b, lru_lambda, na_rpb, final_norm_w):
    rope = axial_rope(x.shape[1], MLSTM_DH, x.dtype)
    h_lat, h_ctx = x, ctx
    for layer in range(DEPTH):
        last = layer == DEPTH - 1
        sx1, cx1, gx1, sx2, cx2, gx2 = ada_modulation(c, ada_w[layer], ada_b[layer])
        sc1, cc1, gc1, sc2, cc2, gc2 = ada_modulation(c_ctx[None], ada_w[layer], ada_b[layer])
        nx = modulate(rms_norm(h_lat), sx1, cx1)
        nc = modulate(rms_norm(h_ctx), sc1, cc1)
        if layer % 2 == 0:
            e = layer // 2
            ox, oc = even_mixer(nx, nc, rope, not last, ev_in_w[e], mix_out_w[layer], ml_gate_b[e], ml_norm_w[e],
                                rw_mu[e], rw_w0[e], rw_w_up[e], rw_a0[e], rw_a_up[e], rw_g_up[e], rw_k_k[e],
                                rw_k_a[e], rw_r_k[e], rw_ln_w[e], rw_ln_b[e])
        else:
            o = layer // 2
            ox, oc = odd_mixer(nx, nc, not last, od_in_w[o], mix_out_w[layer], lru_conv_w[o], lru_conv_b[o],
                               lru_gate_w[o], lru_gate_b[o], lru_lambda[o], na_rpb[o])
        h_lat = h_lat + gx1 * ox
        h_lat = h_lat + gx2 * sq_relu_mlp(modulate(rms_norm(h_lat), sx2, cx2), mlp_w1[layer], mlp_w2[layer])
        if not last:
            h_ctx = h_ctx + gc1 * oc
            h_ctx = h_ctx + gc2 * sq_relu_mlp(modulate(rms_norm(h_ctx), sc2, cc2), mlp_w1[layer], mlp_w2[layer])
    return rms_norm(h_lat) * final_norm_w
```

```cpp
#include <hip/hip_runtime.h>
#include <hip/hip_cooperative_groups.h>
#include <cstdio>
#include <cstdint>
namespace cg = cooperative_groups;
#define GSYNC() xcd_barrier(xb)
#define SKIP_EVEN 0
#define EVMASK 127
#define SKIP_ODD 0
#define SKIP_RWKV 0
#define SKIP_MLSTM 0

typedef unsigned short bf16_t;
typedef short bf16x8 __attribute__((ext_vector_type(8)));
typedef float f32x4 __attribute__((ext_vector_type(4)));
typedef float f32x2 __attribute__((ext_vector_type(2)));
typedef unsigned u32x4 __attribute__((ext_vector_type(4)));
typedef unsigned u32x2 __attribute__((ext_vector_type(2)));
#define GL __attribute__((address_space(1)))

constexpr int ML = 32768, MC = 4096, MT = ML + MC;
constexpr size_t SU = 37748736ull;
constexpr size_t OFF_HCTX = 4096;
constexpr size_t OFF_MOD = OFF_HCTX + 16777216ull;
constexpr size_t OFF_ROPEC = OFF_MOD + 1671168ull;
constexpr size_t OFF_ROPES = OFF_ROPEC + 524288ull;
constexpr size_t OFF_GATES = OFF_ROPES + 524288ull;
constexpr size_t OFF_WTIN = OFF_GATES + 2359296ull;
constexpr size_t OFF_WTOUT = OFF_WTIN + 8388608ull;
constexpr size_t OFF_WT1 = OFF_WTOUT + 2097152ull;
constexpr size_t OFF_WT2 = OFF_WT1 + 8388608ull;
constexpr size_t OFF_WUP = OFF_WT2 + 8388608ull;
constexpr size_t OFF_AUP = OFF_WUP + 131072ull;
constexpr size_t OFF_GUP = OFF_AUP + 131072ull;
constexpr size_t OFF_GWT = OFF_GUP + 131072ull;
constexpr size_t OFF_BAR = OFF_GWT + 262144ull;
constexpr size_t OFF_ARENA = 50331648ull;
static_assert(OFF_BAR + 16384ull <= OFF_ARENA, "persistent region overflow");

struct Params {
  const float *x, *c, *ctx, *c_ctx, *ada_w, *ada_b, *mix_out_w, *mlp_w1, *mlp_w2, *ev_in_w, *ml_gate_b, *ml_norm_w,
      *rw_mu, *rw_w0, *rw_w_up, *rw_a0, *rw_a_up, *rw_g_up, *rw_k_k, *rw_k_a, *rw_r_k, *rw_ln_w, *rw_ln_b, *od_in_w,
      *lru_conv_w, *lru_conv_b, *lru_gate_w, *lru_gate_b, *lru_lambda, *na_rpb, *final_norm_w;
  float* out;
  char* ws;
};

__device__ __forceinline__ float bf2f(unsigned h) { return __uint_as_float(h << 16); }
__device__ __forceinline__ float bflo(unsigned u) { return __uint_as_float(u << 16); }
__device__ __forceinline__ float bfhi(unsigned u) { return __uint_as_float(u & 0xffff0000u); }
typedef __bf16 bf16x2_t __attribute__((ext_vector_type(2)));
__device__ __forceinline__ unsigned pk2(float lo, float hi) {
  f32x2 v = {lo, hi};
  bf16x2_t b = __builtin_convertvector(v, bf16x2_t);
  return __builtin_bit_cast(unsigned, b);
}
__device__ __forceinline__ bf16_t f2bf(float f) { return (bf16_t)(pk2(f, 0.f) & 0xffffu); }
__device__ __forceinline__ u32x2 pk4(f32x4 v) { u32x2 r; r.x = pk2(v[0], v[1]); r.y = pk2(v[2], v[3]); return r; }
__device__ __forceinline__ void unpack8(u32x4 u, float* f) {
  f[0] = bflo(u.x); f[1] = bfhi(u.x); f[2] = bflo(u.y); f[3] = bfhi(u.y);
  f[4] = bflo(u.z); f[5] = bfhi(u.z); f[6] = bflo(u.w); f[7] = bfhi(u.w);
}
__device__ __forceinline__ u32x4 pack8(const float* f) {
  u32x4 r; r.x = pk2(f[0], f[1]); r.y = pk2(f[2], f[3]); r.z = pk2(f[4], f[5]); r.w = pk2(f[6], f[7]); return r;
}
__device__ __forceinline__ float sigm(float x) { return 1.f / (1.f + __expf(-x)); }
__device__ __forceinline__ f32x4 mfma16(bf16x8 a, bf16x8 b, f32x4 c) { return __builtin_amdgcn_mfma_f32_16x16x32_bf16(a, b, c, 0, 0, 0); }
template <class T> __device__ __forceinline__ T* opq_(T* p) {
  unsigned lo = __builtin_amdgcn_readfirstlane((unsigned)(uintptr_t)p);
  unsigned hi = __builtin_amdgcn_readfirstlane((unsigned)((uintptr_t)p >> 32));
  asm volatile("" : "+s"(lo), "+s"(hi));
  return (T*)(((uintptr_t)hi << 32) | (uintptr_t)lo);
}
#define OPQ(x) x = opq_(x)
__device__ __forceinline__ int tid_() { int t = threadIdx.x; asm volatile("" : "+v"(t)); return t; }
__device__ __forceinline__ int gdim_() { int t = gridDim.x; asm volatile("" : "+s"(t)); return t; }
__device__ __forceinline__ int bid_() { int t = blockIdx.x; asm volatile("" : "+s"(t)); return t; }
__device__ __forceinline__ float* hrow2(float* out, float* hctx, int row) {
  return row < ML ? out + (size_t)row * 1024 : hctx + (size_t)(row - ML) * 1024;
}
__device__ __forceinline__ int mrow_of(int row) { return row < ML ? (row >> 11) : 16; }
template <int CTRL> __device__ __forceinline__ float dppf(float x) {
  return __int_as_float(__builtin_amdgcn_update_dpp(0, __float_as_int(x), CTRL, 0xF, 0xF, true));
}
__device__ __forceinline__ float red8(float x) {
  x += dppf<0xB1>(x); x += dppf<0x4E>(x); x += dppf<0x141>(x); return x;
}
__device__ __forceinline__ float wave_sum(float v) {
#pragma unroll
  for (int o = 32; o > 0; o >>= 1) v += __shfl_xor(v, o);
  return v;
}

__device__ __forceinline__ void convT_tile(const float* src, int N, int k0, int n0, bf16_t* dst, int ldd, float* tile) {
  const int tidq = tid_(); const int gdq = gdim_(); const int bidq = bid_(); (void)gdq; (void)bidq;
  OPQ(src); OPQ(dst);
  const int t = tidq, c4 = (t & 15) * 4, r = t >> 4;
#pragma unroll
  for (int i = 0; i < 4; ++i) {
    const int k = r + 16 * i;
    f32x4 v = {0.f, 0.f, 0.f, 0.f};
    if (n0 + c4 < N) v = *(const GL f32x4*)(src + (size_t)(k0 + k) * N + n0 + c4);
    tile[k * 65 + c4 + 0] = v[0]; tile[k * 65 + c4 + 1] = v[1]; tile[k * 65 + c4 + 2] = v[2]; tile[k * 65 + c4 + 3] = v[3];
  }
  __syncthreads();
  const int n = t >> 2, kq = (t & 3) * 16;
  float f[16];
#pragma unroll
  for (int j = 0; j < 16; ++j) f[j] = tile[(kq + j) * 65 + n];
  bf16_t* d = dst + (size_t)(n0 + n) * ldd + k0 + kq;
  *(GL u32x4*)d = pack8(f);
  *(GL u32x4*)(d + 8) = pack8(f + 8);
  __syncthreads();
}
__device__ __forceinline__ void conv_matrix(const float* src, int K, int N, int Npad, bf16_t* dst, int ldd, float* tile) {
  const int tidq = tid_(); const int gdq = gdim_(); const int bidq = bid_(); (void)gdq; (void)bidq;
  const int ntk = K / 64, ntn = Npad / 64;
  for (int t = bidq; t < ntk * ntn; t += gdq) convT_tile(src, N, (t % ntk) * 64, (t / ntk) * 64, dst, ldd, tile);
}
__device__ __forceinline__ void ph_convert(const Params& p, int l, char* smem) {
  const int tidq = tid_(); const int gdq = gdim_(); const int bidq = bid_(); (void)gdq; (void)bidq;
  float* tile = (float*)smem;
  char* ws = p.ws;
  if ((l & 1) == 0) {
    const int e = l >> 1;
    conv_matrix(p.ev_in_w + (size_t)e * 1024 * 3984, 1024, 3984, 4096, (bf16_t*)(ws + OFF_WTIN), 1024, tile);
    for (int d = 0; d < 2; ++d) {
      conv_matrix(p.rw_w_up + (size_t)(e * 2 + d) * 64 * 512, 64, 512, 512, (bf16_t*)(ws + OFF_WUP) + d * 512 * 64, 64, tile);
      conv_matrix(p.rw_a_up + (size_t)(e * 2 + d) * 64 * 512, 64, 512, 512, (bf16_t*)(ws + OFF_AUP) + d * 512 * 64, 64, tile);
    }
    conv_matrix(p.rw_g_up + (size_t)e * 128 * 512, 128, 512, 512, (bf16_t*)(ws + OFF_GUP), 128, tile);
  } else {
    const int o = l >> 1;
    conv_matrix(p.od_in_w + (size_t)o * 1024 * 2560, 1024, 2560, 2560, (bf16_t*)(ws + OFF_WTIN), 1024, tile);
    for (int t = bidq; t < 32; t += gdq) {
      const int zg = t >> 3, n = t & 7;
      convT_tile(p.lru_gate_w + (size_t)(((o * 4 + zg) * 8 + n)) * 4096, 64, 0, 0, (bf16_t*)(ws + OFF_GWT) + (size_t)n * 256 * 64 + zg * 64 * 64, 64, tile);
    }
  }
  conv_matrix(p.mix_out_w + (size_t)l * 1024 * 1024, 1024, 1024, 1024, (bf16_t*)(ws + OFF_WTOUT), 1024, tile);
  conv_matrix(p.mlp_w1 + (size_t)l * 1024 * 4096, 1024, 4096, 4096, (bf16_t*)(ws + OFF_WT1), 1024, tile);
  conv_matrix(p.mlp_w2 + (size_t)l * 4096 * 1024, 4096, 1024, 1024, (bf16_t*)(ws + OFF_WT2), 4096, tile);
}

__device__ __forceinline__ void ph_prologue(const Params& p, char* smem) {
  const int tidq = tid_(); const int gdq = gdim_(); const int bidq = bid_(); (void)gdq; (void)bidq;
  const int gtid = bidq * 256 + tidq, gsz = gdq * 256;
  {
    float* rc = (float*)(p.ws + OFF_ROPEC); float* rs = (float*)(p.ws + OFF_ROPES);
    for (int i = gtid; i < 2048 * 64; i += gsz) {
      const int t = i >> 6, f = i & 63;
      const float pos = (f < 32) ? (float)(t >> 6) : (float)(t & 63);
      const float inv = powf(10000.0f, -(float)(f & 31) / 32.0f);
      const float ang = pos * inv;
      rc[i] = cosf(ang); rs[i] = sinf(ang);
    }
  }
  float* s = (float*)smem;
  float* mod = (float*)(p.ws + OFF_MOD);
  for (int item = bidq; item < 384; item += gdq) {
    const int l = item / 96, n0 = (item % 96) * 64;
    for (int idx = tidq; idx < 17 * 1024; idx += 256) {
      const int r = idx >> 10, k = idx & 1023;
      const float cv = r < 16 ? p.c[r * 1024 + k] : p.c_ctx[k];
      s[idx] = cv / (1.f + expf(-cv));
    }
    __syncthreads();
    const int kq = tidq >> 6, nn = tidq & 63;
    float acc[17];
#pragma unroll
    for (int r = 0; r < 17; ++r) acc[r] = 0.f;
    const float* wp = p.ada_w + ((size_t)l * 1024 + kq * 256) * 6144 + n0 + nn;
    for (int k = 0; k < 256; k += 4) {
      const float w0 = wp[(size_t)(k + 0) * 6144], w1 = wp[(size_t)(k + 1) * 6144], w2 = wp[(size_t)(k + 2) * 6144], w3 = wp[(size_t)(k + 3) * 6144];
#pragma unroll
      for (int r = 0; r < 17; ++r) {
        const f32x4 sv = *(const f32x4*)(s + r * 1024 + kq * 256 + k);
        acc[r] += sv[0] * w0 + sv[1] * w1 + sv[2] * w2 + sv[3] * w3;
      }
    }
    __syncthreads();
#pragma unroll
    for (int r = 0; r < 17; ++r) s[(kq * 17 + r) * 64 + nn] = acc[r];
    __syncthreads();
    for (int idx = tidq; idx < 17 * 64; idx += 256) {
      const int r = idx >> 6, n = idx & 63;
      float v = p.ada_b[l * 6144 + n0 + n];
#pragma unroll
      for (int q = 0; q < 4; ++q) v += s[(q * 17 + r) * 64 + n];
      mod[((size_t)l * 17 + r) * 6144 + n0 + n] = v;
    }
    __syncthreads();
  }
}

__device__ __forceinline__ void ph_norm(const Params& p, int l, int which, int Mrows, bf16_t* xn, bool from_input = false) {
  const int tidq = tid_(); const int gdq = gdim_(); const int bidq = bid_(); (void)gdq; (void)bidq;
  const int lane = tidq & 63;
  float* out_ = from_input ? (float*)p.x : p.out; char* ws_ = p.ws; OPQ(out_); OPQ(ws_); OPQ(xn);
  float* hctx_ = from_input ? (float*)p.ctx : (float*)(ws_ + OFF_HCTX); OPQ(hctx_);
  const float* mod = (const float*)(ws_ + OFF_MOD) + (size_t)l * 17 * 6144 + which * 3072;
  constexpr int R = 4;
  const int nw = gdq * 4;
  for (int row0 = bidq * 4 + (tidq >> 6); row0 < Mrows; row0 += nw * R) {
    f32x4 v[R][4];
#pragma unroll
    for (int j = 0; j < R; ++j) {
      const int row = row0 + j * nw;
      if (row < Mrows) {
        const float* h = hrow2(out_, hctx_, row);
#pragma unroll
        for (int i = 0; i < 4; ++i) v[j][i] = *(const GL f32x4*)(h + i * 256 + lane * 4);
      }
    }
#pragma unroll
    for (int j = 0; j < R; ++j) {
      const int row = row0 + j * nw;
      if (row < Mrows) {
        float ss = 0.f;
#pragma unroll
        for (int i = 0; i < 4; ++i) ss += v[j][i][0] * v[j][i][0] + v[j][i][1] * v[j][i][1] + v[j][i][2] * v[j][i][2] + v[j][i][3] * v[j][i][3];
        ss = wave_sum(ss);
        const float rstd = rsqrtf(ss * (1.f / 1024.f) + 1e-6f);
        const float* m = mod + (size_t)mrow_of(row) * 6144;
#pragma unroll
        for (int i = 0; i < 4; ++i) {
          const int col = i * 256 + lane * 4;
          const f32x4 sh = *(const GL f32x4*)(m + col), sc = *(const GL f32x4*)(m + 1024 + col);
          f32x4 o = v[j][i] * rstd * (sc + 1.f) + sh;
          *(GL u32x2*)(xn + (size_t)row * 1024 + col) = pk4(o);
        }
      }
    }
  }
}
__device__ __forceinline__ void ph_final_norm(const Params& p) {
  const int tidq = tid_(); const int gdq = gdim_(); const int bidq = bid_(); (void)gdq; (void)bidq;
  const int lane = tidq & 63;
  float* out_ = p.out; OPQ(out_);
  constexpr int R = 4;
  const int nw = gdq * 4;
  for (int row0 = bidq * 4 + (tidq >> 6); row0 < ML; row0 += nw * R) {
    f32x4 v[R][4];
#pragma unroll
    for (int j = 0; j < R; ++j) {
      const int row = row0 + j * nw;
      if (row < ML) {
#pragma unroll
        for (int i = 0; i < 4; ++i) v[j][i] = *(const GL f32x4*)(out_ + (size_t)row * 1024 + i * 256 + lane * 4);
      }
    }
#pragma unroll
    for (int j = 0; j < R; ++j) {
      const int row = row0 + j * nw;
      if (row < ML) {
        float ss = 0.f;
#pragma unroll
        for (int i = 0; i < 4; ++i) ss += v[j][i][0] * v[j][i][0] + v[j][i][1] * v[j][i][1] + v[j][i][2] * v[j][i][2] + v[j][i][3] * v[j][i][3];
        ss = wave_sum(ss);
        const float rstd = rsqrtf(ss * (1.f / 1024.f) + 1e-6f);
#pragma unroll
        for (int i = 0; i < 4; ++i) {
          const int col = i * 256 + lane * 4;
          const f32x4 w = *(const GL f32x4*)(p.final_norm_w + col);
          *(GL f32x4*)(out_ + (size_t)row * 1024 + col) = v[j][i] * rstd * w;
        }
      }
    }
  }
}

template <int MI, class Epi>
__device__ __forceinline__ void gemm_phase_t(const bf16_t* A, int lda, int jump_at, int jump, const bf16_t* Bt, int ldb,
                           int Mrows, int N, int K, Epi epi, char* smem, int a_grp = 0) {
  const int tidq = tid_(); const int gdq = gdim_(); const int bidq = bid_();
  OPQ(A); OPQ(Bt); epi.launder();
  const int tid = tidq, lane = tid & 63, w = tid >> 6, wr = w >> 1, wc = w & 1, fr = lane & 15, fq = lane >> 4;
  constexpr int BM = MI * 32;
  const int ntm = Mrows / BM, ntn = (N + 127) / 128, nk = K / 64;
  char* As = smem;
  char* Bs = As + BM * 128;
  const int lrow = tid >> 3, lc = (tid & 7) * 8;
  const int lsw = ((tid & 7) ^ ((lrow >> 1) & 7)) << 4;
  const int rsw = (fr >> 1) & 7;
  const int xcd = bidq & 7, slot = bidq >> 3, nslot = gdq >> 3;
  const bool xmap = ((ntm & 7) == 0) && ((gdq & 7) == 0);
  const int ntml = ntm >> 3;
  const int tper = xmap ? ntml * ntn : ntm * ntn;
  const int tj0 = xmap ? slot : bidq, tjs = xmap ? nslot : gdq;
  const int BW = (ntn >= 16) ? 4 : 8;
#define TILE_OF(TJ, M0, N0) { int tm_, tn_; \
    if (xmap) { const int band_ = (TJ) / (BW * ntn), rem_ = (TJ) - band_ * BW * ntn; const int rib_ = min(BW, ntml - band_ * BW); \
      tn_ = rem_ / rib_; tm_ = (band_ * BW + (rem_ - tn_ * rib_)) * 8 + xcd; } \
    else { tm_ = (TJ) / ntn; tn_ = (TJ) % ntn; } \
    M0 = tm_ * BM; N0 = tn_ * 128; }
  u32x4 ra[MI], rb[4];
#define GLOAD(AP, BP, KT) { const int k0_ = (KT) * 64 + lc, ka_ = k0_ + (k0_ >= jump_at ? jump : 0); \
      _Pragma("unroll") for (int i = 0; i < MI; ++i) ra[i] = *(const GL u32x4*)((AP) + (size_t)(32 * i) * lda + ka_); \
      _Pragma("unroll") for (int i = 0; i < 4; ++i) rb[i] = *(const GL u32x4*)((BP) + (size_t)(32 * i) * ldb + k0_); }
  if (tj0 < tper) {
    int m0, n0; TILE_OF(tj0, m0, n0);
    GLOAD(A + (size_t)(m0 + lrow) * lda + (a_grp ? (n0 / a_grp) * K : 0), Bt + (size_t)(n0 + lrow) * ldb, 0);
  }
  for (int tj = tj0; tj < tper; tj += tjs) {
    int m0, n0; TILE_OF(tj, m0, n0);
    int m1 = m0, n1 = n0;
    const bool has_next = (tj + tjs) < tper;
    if (has_next) TILE_OF(tj + tjs, m1, n1);
    f32x4 acc[MI][4];
#pragma unroll
    for (int i = 0; i < MI; ++i)
#pragma unroll
      for (int j = 0; j < 4; ++j) acc[i][j] = (f32x4){0.f, 0.f, 0.f, 0.f};
    const bf16_t* Ap = A + (size_t)(m0 + lrow) * lda + (a_grp ? (n0 / a_grp) * K : 0);
    const bf16_t* Bp = Bt + (size_t)(n0 + lrow) * ldb;
    const bf16_t* Ap1 = A + (size_t)(m1 + lrow) * lda + (a_grp ? (n1 / a_grp) * K : 0);
    const bf16_t* Bp1 = Bt + (size_t)(n1 + lrow) * ldb;
    if constexpr (MI > 6) { if (tj != tj0) GLOAD(Ap, Bp, 0); }
    for (int kt = 0; kt < nk; ++kt) {
      __syncthreads();
#pragma unroll
      for (int i = 0; i < MI; ++i) *(u32x4*)(As + (lrow + 32 * i) * 128 + lsw) = ra[i];
#pragma unroll
      for (int i = 0; i < 4; ++i) *(u32x4*)(Bs + (lrow + 32 * i) * 128 + lsw) = rb[i];
      __syncthreads();
      {
        if constexpr (MI <= 6) {
          const bool lastk = (kt + 1 == nk);
          const bf16_t* ap_ = lastk ? Ap1 : Ap;
          const bf16_t* bp_ = lastk ? Bp1 : Bp;
          const int kn_ = lastk ? 0 : kt + 1;
          GLOAD(ap_, bp_, kn_);
        } else {
          GLOAD(Ap, Bp, min(kt + 1, nk - 1));
        }
      }
#pragma unroll
      for (int ks = 0; ks < 2; ++ks) {
        bf16x8 bfr[4];
#pragma unroll
        for (int ni = 0; ni < 4; ++ni) bfr[ni] = *(const bf16x8*)(Bs + (wc * 64 + ni * 16 + fr) * 128 + (((ks * 4 + fq) ^ rsw) << 4));
#pragma unroll
        for (int mi = 0; mi < MI; ++mi) {
          const bf16x8 af = *(const bf16x8*)(As + (wr * (BM / 2) + mi * 16 + fr) * 128 + (((ks * 4 + fq) ^ rsw) << 4));
#pragma unroll
          for (int ni = 0; ni < 4; ++ni) acc[mi][ni] = mfma16(bfr[ni], af, acc[mi][ni]);
        }
      }
    }
#pragma unroll
    for (int mi = 0; mi < MI; ++mi)
#pragma unroll
      for (int ni = 0; ni < 4; ++ni) {
        const int row = m0 + wr * (BM / 2) + mi * 16 + fr, col = n0 + wc * 64 + ni * 16 + fq * 4;
        if (col < N) epi(row, col, acc[mi][ni]);
      }
  }
#undef GLOAD
#undef TILE_OF
}

template <class Epi>
__device__ __forceinline__ void gemm_phase(const bf16_t* A, int lda, int jump_at, int jump, const bf16_t* Bt, int ldb,
                           int Mrows, int N, int K, Epi epi, char* smem) {
  if (N <= 512) gemm_phase_t<4>(A, lda, jump_at, jump, Bt, ldb, Mrows, N, K, epi, smem);
  else if (N == 1024 && Mrows == MT) gemm_phase_t<6>(A, lda, jump_at, jump, Bt, ldb, Mrows, N, K, epi, smem);
  else gemm_phase_t<8>(A, lda, jump_at, jump, Bt, ldb, Mrows, N, K, epi, smem);
}

struct EpiInEven {
  bf16_t* zm; bf16_t* zw; float* gates;
  __device__ __forceinline__ void launder() { OPQ(zm); OPQ(zw); OPQ(gates); }
  __device__ __forceinline__ void operator()(int row, int col, f32x4 v) const {
    if (col < 2048) *(GL u32x2*)(zm + (size_t)row * 2048 + col) = pk4(v);
    else if (col < 2064) *(GL f32x4*)(gates + (size_t)row * 16 + (col - 2048)) = v;
    else *(GL u32x2*)(zw + (size_t)row * 1920 + (col - 2064)) = pk4(v);
  }
};
struct EpiStore {
  bf16_t* o; int ld;
  __device__ __forceinline__ void launder() { OPQ(o); }
  __device__ __forceinline__ void operator()(int row, int col, f32x4 v) const { *(GL u32x2*)(o + (size_t)row * ld + col) = pk4(v); }
};
struct EpiResid {
  float* out; float* hctx; const float* gate; const float* srcl; const float* srcc;
  __device__ __forceinline__ void launder() { OPQ(out); OPQ(hctx); OPQ(gate); OPQ(srcl); OPQ(srcc); }
  __device__ __forceinline__ void operator()(int row, int col, f32x4 v) const {
    float* h = hrow2(out, hctx, row) + col;
    const float* hs = (row < ML ? srcl + (size_t)row * 1024 : srcc + (size_t)(row - ML) * 1024) + col;
    const f32x4 g = *(const GL f32x4*)(gate + (size_t)mrow_of(row) * 6144 + col);
    f32x4 hv = *(const GL f32x4*)hs;
    hv += g * v;
    *(GL f32x4*)h = hv;
  }
};
struct EpiMlp1 {
  bf16_t* u;
  __device__ __forceinline__ void launder() { OPQ(u); }
  __device__ __forceinline__ void operator()(int row, int col, f32x4 v) const {
    f32x4 r;
#pragma unroll
    for (int i = 0; i < 4; ++i) { const float t = fmaxf(v[i], 0.f); r[i] = t * t; }
    *(GL u32x2*)(u + (size_t)row * 4096 + col) = pk4(r);
  }
};
struct EpiLd {
  _Float16* ld; const float* w0;
  __device__ __forceinline__ void launder() { OPQ(ld); OPQ(w0); }
  __device__ __forceinline__ void operator()(int row, int col, f32x4 v) const {
    const f32x4 b = *(const GL f32x4*)(w0 + col);
    _Float16 o[4];
#pragma unroll
    for (int i = 0; i < 4; ++i) o[i] = (_Float16)(-0.60653065971f * sigm(v[i] + b[i]));
    *(GL u32x2*)(ld + (size_t)row * 512 + col) = *(const u32x2*)o;
  }
};
struct EpiAlr {
  bf16_t* alr; const float* a0;
  __device__ __forceinline__ void launder() { OPQ(alr); OPQ(a0); }
  __device__ __forceinline__ void operator()(int row, int col, f32x4 v) const {
    const f32x4 b = *(const GL f32x4*)(a0 + col);
    f32x4 r;
#pragma unroll
    for (int i = 0; i < 4; ++i) r[i] = sigm(v[i] + b[i]);
    *(GL u32x2*)(alr + (size_t)row * 512 + col) = pk4(r);
  }
};
struct EpiLdV {
  _Float16* ld; const float* w0;
  __device__ __forceinline__ void launder() { OPQ(ld); OPQ(w0); }
  __device__ __forceinline__ void operator()(int row, int colv, f32x4 v) const {
    const int g = colv >> 9, col = colv & 511;
    const f32x4 b = *(const GL f32x4*)(w0 + colv);
    _Float16 o[4];
#pragma unroll
    for (int i = 0; i < 4; ++i) o[i] = (_Float16)(-0.60653065971f * sigm(v[i] + b[i]));
    *(GL u32x2*)(ld + ((size_t)g * MT + row) * 512 + col) = *(const u32x2*)o;
  }
};
struct EpiGates {
  bf16_t* g; const float* gb;
  __device__ __forceinline__ void launder() { OPQ(g); OPQ(gb); }
  __device__ __forceinline__ void operator()(int row, int colv, f32x4 v) const {
    const int n = colv >> 8, cl = colv & 255;
    const int zg = cl >> 6, d = cl & 63, c = zg * 512 + n * 64 + d;
    const f32x4 b = *(const GL f32x4*)(gb + c);
    f32x4 r;
#pragma unroll
    for (int i = 0; i < 4; ++i) r[i] = sigm(v[i] + b[i]);
    *(GL u32x2*)(g + (size_t)row * 2048 + c) = pk4(r);
  }
};

__device__ __forceinline__ void ph_rope(const Params& p, bf16_t* zm) {
  const int tidq = tid_(); const int gdq = gdim_(); const int bidq = bid_(); (void)gdq; (void)bidq;
  OPQ(zm);
  const int lane = tidq & 63;
  const int part = lane >> 5, head = (lane >> 3) & 3, d = (lane & 7) * 8;
  char* ws_ = p.ws; OPQ(ws_);
  const float* rc = (const float*)(ws_ + OFF_ROPEC); const float* rs = (const float*)(ws_ + OFF_ROPES);
  const float sc = part ? 0.08838834764831845f : 1.f;
  constexpr int R = 4;
  const int nw = gdq * 4;
  for (int row0 = bidq * 4 + (tidq >> 6); row0 < MT; row0 += nw * R) {
    u32x4 a[R], b[R];
    f32x4 c0[R], c1[R], s0[R], s1[R];
#pragma unroll
    for (int j = 0; j < R; ++j) {
      const int row = row0 + j * nw;
      if (row < MT) {
        bf16_t* base = zm + (size_t)row * 2048 + part * 512 + head * 128;
        a[j] = *(const GL u32x4*)(base + d); b[j] = *(const GL u32x4*)(base + 64 + d);
        if (row < ML) {
          const int t = row & 2047;
          c0[j] = *(const GL f32x4*)(rc + t * 64 + d); c1[j] = *(const GL f32x4*)(rc + t * 64 + d + 4);
          s0[j] = *(const GL f32x4*)(rs + t * 64 + d); s1[j] = *(const GL f32x4*)(rs + t * 64 + d + 4);
        }
      }
    }
#pragma unroll
    for (int j = 0; j < R; ++j) {
      const int row = row0 + j * nw;
      if (row < MT) {
        bf16_t* base = zm + (size_t)row * 2048 + part * 512 + head * 128;
        float x1[8], x2[8], o1[8], o2[8];
        unpack8(a[j], x1); unpack8(b[j], x2);
        if (row < ML) {
#pragma unroll
          for (int i = 0; i < 8; ++i) {
            const float c = i < 4 ? c0[j][i & 3] : c1[j][i & 3], s = i < 4 ? s0[j][i & 3] : s1[j][i & 3];
            o1[i] = (x1[i] * c - x2[i] * s) * sc; o2[i] = (x1[i] * s + x2[i] * c) * sc;
          }
        } else {
#pragma unroll
          for (int i = 0; i < 8; ++i) { o1[i] = x1[i] * sc; o2[i] = x2[i] * sc; }
        }
        if (row < ML || part) { *(GL u32x4*)(base + d) = pack8(o1); *(GL u32x4*)(base + 64 + d) = pack8(o2); }
      }
    }
  }
}

__device__ __forceinline__ void mlstm_item(const Params& p, int e, int item, const bf16_t* zm, const float* gates, bf16_t* hm, char* smem) {
  const int tidq = tid_(); const int gdq = gdim_(); const int bidq = bid_(); (void)gdq; (void)bidq;
  OPQ(zm); OPQ(gates); OPQ(hm);
  const int eh = item & 1, hh = (item >> 1) & 3, b = (item >> 3) & 15, dir = item >> 7;
  const int tid = tidq, lane = tid & 63, w = tid >> 6, fr = lane & 15, fq = lane >> 4;
  bf16_t* Vt = (bf16_t*)smem;
  bf16_t* Kt = (bf16_t*)(smem + 11520);
  bf16_t* Kn = (bf16_t*)(smem + 11520);
  bf16_t* Ct = (bf16_t*)(smem + 29952);
  bf16_t* Ps = (bf16_t*)(smem + 51712);
  float* fu = (float*)(smem + 60928);
  float* fM = fu + 64;
  float* fb = fu + 128;
  for (int i = tid; i < 80 * 136 / 2; i += 256) ((unsigned*)Ct)[i] = 0u;
  for (int i = tid; i < 16 * 72; i += 256) Vt[64 * 72 + i] = (i < 72) ? (bf16_t)0x3F80 : (bf16_t)0;
  f32x4 acc[2][5];
#pragma unroll
  for (int i = 0; i < 2; ++i)
#pragma unroll
    for (int j = 0; j < 5; ++j) acc[i][j] = (f32x4){0.f, 0.f, 0.f, 0.f};
  float m = 0.f;
  const float gbi = p.ml_gate_b[e * 16 + dir * 8 + hh], gbf = p.ml_gate_b[e * 16 + dir * 8 + 4 + hh];
  const int tq = 16 * w + fr;
  int rbase = 0, rstep = 1;
  auto setrow = [&](int c) {
    const bool isctx = c < 4;
    const int cc = isctx ? c : c - 4, len = isctx ? 256 : 2048, base = isctx ? ML + b * 256 : b * 2048;
    rbase = dir ? base + len - 1 - cc * 64 : base + cc * 64;
    rstep = dir ? -1 : 1;
  };
#define MROW(pp) (rbase + rstep * (pp))
  u32x4 vv[2], kv[4];
  bf16x8 qfn[4];
  float gli = 0.f, gfr = 0.f;
  auto prefetch = [&](int c) {
    setrow(c);
#pragma unroll
    for (int i = 0; i < 2; ++i) { const int idx = tid + 256 * i, s = idx >> 3, e8 = (idx & 7) * 8; vv[i] = *(const GL u32x4*)(zm + (size_t)MROW(s) * 2048 + 1024 + hh * 128 + eh * 64 + e8); }
#pragma unroll
    for (int i = 0; i < 4; ++i) { const int idx = tid + 256 * i, s = idx >> 4, d8 = (idx & 15) * 8; kv[i] = *(const GL u32x4*)(zm + (size_t)MROW(s) * 2048 + 512 + hh * 128 + d8); }
#pragma unroll
    for (int ks = 0; ks < 4; ++ks) qfn[ks] = *(const GL bf16x8*)(zm + (size_t)MROW(tq) * 2048 + hh * 128 + ks * 32 + fq * 8);
    if (w == 0) { const float* g = gates + (size_t)MROW(lane) * 16; gli = g[dir * 4 + hh]; gfr = g[8 + dir * 4 + hh]; }
  };
  prefetch(0);
  __syncthreads();
  for (int c = 0; c < 36; ++c) {
    setrow(c);
    if (w == 0) {
      const float li = gli + gbi;
      const float fraw = gfr + gbf;
      const float lf = fminf(fraw, 0.f) - log1pf(expf(-fabsf(fraw)));
      float bc = lf;
#pragma unroll
      for (int o = 1; o < 64; o <<= 1) { const float t = __shfl_up(bc, o); if (lane >= o) bc += t; }
      const float u = li - bc;
      float pm = u;
#pragma unroll
      for (int o = 1; o < 64; o <<= 1) { const float t = __shfl_up(pm, o); if (lane >= o) pm = fmaxf(pm, t); }
      fu[lane] = u; fM[lane] = fmaxf(m, pm); fb[lane] = bc;
    }
#pragma unroll
    for (int i = 0; i < 2; ++i) {
      const int idx = tid + 256 * i, s = idx >> 3, e8 = (idx & 7) * 8;
      const unsigned uu[4] = {vv[i].x, vv[i].y, vv[i].z, vv[i].w};
#pragma unroll
      for (int j = 0; j < 4; ++j) { Vt[(e8 + 2 * j) * 72 + s] = (bf16_t)(uu[j] & 0xffffu); Vt[(e8 + 2 * j + 1) * 72 + s] = (bf16_t)(uu[j] >> 16); }
    }
#pragma unroll
    for (int i = 0; i < 4; ++i) { const int idx = tid + 256 * i, s = idx >> 4, d8 = (idx & 15) * 8; *(u32x4*)(Kn + s * 136 + d8) = kv[i]; }
    bf16x8 qf[4];
#pragma unroll
    for (int ks = 0; ks < 4; ++ks) qf[ks] = qfn[ks];
    __syncthreads();
    const float M63 = fM[63];
    const float Mt = fM[tq];
#pragma unroll
    for (int ni = 0; ni < 4; ++ni) {
      f32x4 sa = {0.f, 0.f, 0.f, 0.f};
#pragma unroll
      for (int ks = 0; ks < 4; ++ks) {
        const bf16x8 kfr = *(const bf16x8*)(Kn + (ni * 16 + fr) * 136 + ks * 32 + fq * 8);
        sa = mfma16(kfr, qf[ks], sa);
      }
      const int s0 = ni * 16 + fq * 4;
      const f32x4 u4 = *(const f32x4*)(fu + s0);
      f32x4 pv;
#pragma unroll
      for (int j = 0; j < 4; ++j) pv[j] = (s0 + j <= tq) ? sa[j] * __expf(u4[j] - Mt) : 0.f;
      *(u32x2*)(Ps + tq * 72 + s0) = pk4(pv);
    }
    __syncthreads();
#pragma unroll
    for (int i = 0; i < 4; ++i) {
      const int idx = tid + 256 * i, s = idx >> 4, d8 = (idx & 15) * 8;
      const float wk = __expf(fu[s] - M63);
      float kf[8];
      unpack8(kv[i], kf);
#pragma unroll
      for (int j = 0; j < 8; ++j) Kt[(d8 + j) * 72 + s] = f2bf(kf[j] * wk);
    }
    const int orow = MROW(tq);
    if (c + 1 < 36) prefetch(c + 1);
    f32x4 aC[5], aP[5];
#pragma unroll
    for (int ni = 0; ni < 5; ++ni) { aC[ni] = (f32x4){0.f, 0.f, 0.f, 0.f}; aP[ni] = (f32x4){0.f, 0.f, 0.f, 0.f}; }
#pragma unroll
    for (int ni = 0; ni < 5; ++ni)
#pragma unroll
      for (int ks = 0; ks < 4; ++ks) {
        const bf16x8 cf = *(const bf16x8*)(Ct + (ni * 16 + fr) * 136 + ks * 32 + fq * 8);
        aC[ni] = mfma16(cf, qf[ks], aC[ni]);
      }
#pragma unroll
    for (int ks = 0; ks < 2; ++ks) {
      const bf16x8 pf = *(const bf16x8*)(Ps + tq * 72 + ks * 32 + fq * 8);
#pragma unroll
      for (int ni = 0; ni < 5; ++ni) {
        const bf16x8 vf = *(const bf16x8*)(Vt + (ni * 16 + fr) * 72 + ks * 32 + fq * 8);
        aP[ni] = mfma16(vf, pf, aP[ni]);
      }
    }
    {
      const float wprev = __expf(m - Mt);
      const float dval = wprev * aC[4][0] + aP[4][0];
      const float den = __shfl(dval, fr);
      const float dn = fmaxf(fabsf(den), __expf(-(fb[tq] + Mt)));
      const float inv = 1.f / dn;
      bf16_t* ho = hm + ((size_t)dir * MT + orow) * 512 + hh * 128 + eh * 64 + fq * 4;
#pragma unroll
      for (int ni = 0; ni < 4; ++ni) {
        const f32x4 hv = (aC[ni] * wprev + aP[ni]) * inv;
        *(GL u32x2*)(ho + ni * 16) = pk4(hv);
      }
    }
    const float bend = fb[63];
    __syncthreads();
    const float keep = __expf(m - M63);
#pragma unroll
    for (int mi = 0; mi < 2; ++mi)
#pragma unroll
      for (int ni = 0; ni < 5; ++ni) acc[mi][ni] *= keep;
#pragma unroll
    for (int ks = 0; ks < 2; ++ks) {
      bf16x8 vf[5];
#pragma unroll
      for (int ni = 0; ni < 5; ++ni) vf[ni] = *(const bf16x8*)(Vt + (ni * 16 + fr) * 72 + ks * 32 + fq * 8);
#pragma unroll
      for (int mi = 0; mi < 2; ++mi) {
        const bf16x8 kf = *(const bf16x8*)(Kt + (32 * w + mi * 16 + fr) * 72 + ks * 32 + fq * 8);
#pragma unroll
        for (int ni = 0; ni < 5; ++ni) acc[mi][ni] = mfma16(kf, vf[ni], acc[mi][ni]);
      }
    }
#pragma unroll
    for (int mi = 0; mi < 2; ++mi)
#pragma unroll
      for (int ni = 0; ni < 5; ++ni) *(u32x2*)(Ct + (ni * 16 + fr) * 136 + 32 * w + mi * 16 + fq * 4) = pk4(acc[mi][ni]);
    m = bend + M63;
    __syncthreads();
  }
#undef MROW
}

__device__ __forceinline__ void ph_mlstm_post(const Params& p, int e, const bf16_t* zm, const bf16_t* hm, bf16_t* mix) {
  const int tidq = tid_(); const int gdq = gdim_(); const int bidq = bid_(); (void)gdq; (void)bidq;
  OPQ(zm); OPQ(hm); OPQ(mix);
  const int lane = tidq & 63, c = lane * 8;
  float nw_[8];
#pragma unroll
  for (int i = 0; i < 8; ++i) nw_[i] = p.ml_norm_w[e * 512 + c + i];
  constexpr int R = 4;
  const int nw = gdq * 4;
  for (int row0 = bidq * 4 + (tidq >> 6); row0 < MT; row0 += nw * R) {
    u32x4 ua[R], ub[R], uo[R];
#pragma unroll
    for (int j = 0; j < R; ++j) {
      const int row = row0 + j * nw;
      if (row < MT) {
        ua[j] = *(const GL u32x4*)(hm + (size_t)row * 512 + c);
        ub[j] = *(const GL u32x4*)(hm + ((size_t)MT + row) * 512 + c);
        uo[j] = *(const GL u32x4*)(zm + (size_t)row * 2048 + 1536 + c);
      }
    }
#pragma unroll
    for (int j = 0; j < R; ++j) {
      const int row = row0 + j * nw;
      if (row < MT) {
        float a[8], b2[8], og[8], o[8];
        unpack8(ua[j], a); unpack8(ub[j], b2); unpack8(uo[j], og);
        float ss = 0.f;
#pragma unroll
        for (int i = 0; i < 8; ++i) { a[i] += b2[i]; ss += a[i] * a[i]; }
        ss += __shfl_xor(ss, 1); ss += __shfl_xor(ss, 2); ss += __shfl_xor(ss, 4); ss += __shfl_xor(ss, 8);
        const float rstd = rsqrtf(ss * (1.f / 128.f) + 1e-6f);
#pragma unroll
        for (int i = 0; i < 8; ++i) o[i] = a[i] * rstd * nw_[i] * sigm(og[i]);
        *(GL u32x4*)(mix + (size_t)row * 1024 + c) = pack8(o);
      }
    }
  }
}

__device__ __forceinline__ void ph_rwkv_prep(const Params& p, int e, const bf16_t* zw, bf16_t* zr, bf16_t* alin) {
  const int tidq = tid_(); const int gdq = gdim_(); const int bidq = bid_(); (void)gdq; (void)bidq;
  OPQ(zw); OPQ(zr); OPQ(alin);
  const int lane = tidq & 63;
  const float* mu = p.rw_mu + e * 1920;
  const int nw = gdq * 4;
  for (int row = bidq * 4 + (tidq >> 6); row < MT; row += nw) {
    int t, len;
    if (row < ML) { t = row & 2047; len = 2048; } else { t = (row - ML) & 255; len = 256; }
    const bool hp = t > 0, hn = t < len - 1;
    u32x4 uz[4], up[4], un[4];
#pragma unroll
    for (int q = 0; q < 4; ++q) {
      const int vi = lane + 64 * q;
      if (vi < 240) {
        const int col = vi * 8;
        uz[q] = *(const GL u32x4*)(zw + (size_t)row * 1920 + col);
        up[q] = (u32x4){0u, 0u, 0u, 0u}; un[q] = (u32x4){0u, 0u, 0u, 0u};
        if (hp) up[q] = *(const GL u32x4*)(zw + (size_t)(row - 1) * 1920 + col);
        if (hn) un[q] = *(const GL u32x4*)(zw + (size_t)(row + 1) * 1920 + col);
      }
    }
#pragma unroll
    for (int q = 0; q < 4; ++q) {
      const int vi = lane + 64 * q;
      if (vi < 240) {
        const int col = vi * 8;
        float z[8], zp[8], zn[8], o[8];
        unpack8(uz[q], z); unpack8(up[q], zp); unpack8(un[q], zn);
        const f32x4 m0 = *(const GL f32x4*)(mu + col), m1 = *(const GL f32x4*)(mu + col + 4);
#pragma unroll
        for (int i = 0; i < 8; ++i) {
          const float mm = i < 4 ? m0[i & 3] : m1[i & 3];
          float v = z[i] + mm * (0.5f * (zp[i] + zn[i]) - z[i]);
          if (col >= 1536 && col < 1664) v = tanhf(v);
          else if (col >= 1792) v = sigm(v);
          o[i] = v;
        }
        if (col < 1536) *(GL u32x4*)(zr + (size_t)row * 1536 + col) = pack8(o);
        else *(GL u32x4*)(alin + (size_t)row * 384 + (col - 1536)) = pack8(o);
      }
    }
  }
}

__device__ __forceinline__ void rwkv_item(const Params& p, int e, int item, const bf16_t* zr, const _Float16* ldp, bf16_t* alr, char* smem) {
  const int tidq = tid_(); const int gdq = gdim_(); const int bidq = bid_(); (void)gdq; (void)bidq;
  OPQ(zr); OPQ(ldp); OPQ(alr);
  const int dir = item >> 7, b = (item >> 3) & 15, hd = item & 7;
  const int tid = tidq;
  float* buf = (float*)smem;
  float* ybuf = (float*)(smem + 49152);
  const int ls = tid >> 4, lc = (tid & 15) * 4;
  const int rp = tid >> 3, sub = tid & 7;
  const f32x4 kk4 = *(const GL f32x4*)(p.rw_k_k + e * 512 + hd * 64 + lc);
  const f32x4 ka4 = *(const GL f32x4*)(p.rw_k_a + e * 512 + hd * 64 + lc);
  const _Float16* ldd = ldp + (size_t)dir * MT * 512;
  bf16_t* ald = alr + (size_t)dir * MT * 512;
  auto rowof = [&](int g) -> int {
    if (g < 256) return ML + b * 256 + (dir ? 255 - g : g);
    const int gl = g - 256;
    return b * 2048 + (dir ? 2047 - gl : gl);
  };
  u32x2 r4, k4, v4, l4, a4;
  auto gload = [&](int c) {
    const int row = rowof(c * 16 + ls);
    const bf16_t* zp = zr + (size_t)row * 1536 + hd * 64 + lc;
    r4 = *(const GL u32x2*)zp; k4 = *(const GL u32x2*)(zp + 512); v4 = *(const GL u32x2*)(zp + 1024);
    l4 = *(const GL u32x2*)(ldd + (size_t)row * 512 + hd * 64 + lc);
    a4 = *(const GL u32x2*)(ald + (size_t)row * 512 + hd * 64 + lc);
  };
  auto stage = [&](int nb) {
    float* d = buf + nb * 6 * 1024 + ls * 64 + lc;
    const f32x4 r = {bflo(r4.x), bfhi(r4.x), bflo(r4.y), bfhi(r4.y)};
    const f32x4 k = {bflo(k4.x), bfhi(k4.x), bflo(k4.y), bfhi(k4.y)};
    const f32x4 v = {bflo(v4.x), bfhi(v4.x), bflo(v4.y), bfhi(v4.y)};
    const f32x4 a = {bflo(a4.x), bfhi(a4.x), bflo(a4.y), bfhi(a4.y)};
    _Float16 lh[4]; *(u32x2*)lh = l4;
    f32x4 kk = k * kk4;
    float ss = kk[0] * kk[0] + kk[1] * kk[1] + kk[2] * kk[2] + kk[3] * kk[3];
    ss += __shfl_xor(ss, 1); ss += __shfl_xor(ss, 2); ss += __shfl_xor(ss, 4); ss += __shfl_xor(ss, 8);
    const float inv = 1.f / fmaxf(sqrtf(ss), 1e-12f);
    kk = kk * inv;
    f32x4 wv, kd, bv;
#pragma unroll
    for (int i = 0; i < 4; ++i) { wv[i] = __expf((float)lh[i]); kd[i] = k[i] * (1.f + (a[i] - 1.f) * ka4[i]); bv[i] = kk[i] * a[i]; }
    *(f32x4*)(d + 0 * 1024) = r; *(f32x4*)(d + 1 * 1024) = wv; *(f32x4*)(d + 2 * 1024) = kd;
    *(f32x4*)(d + 3 * 1024) = v; *(f32x4*)(d + 4 * 1024) = kk; *(f32x4*)(d + 5 * 1024) = bv;
  };
  f32x2 S[8];
#pragma unroll
  for (int j = 0; j < 8; ++j) S[j] = (f32x2){0.f, 0.f};
  __syncthreads();
  gload(0);
  stage(0);
  __syncthreads();
  for (int c = 0; c < 144; ++c) {
    if (c + 1 < 144) gload(c + 1);
    const float* cur = buf + (c & 1) * 6 * 1024;
    float* yb = ybuf + (c & 1) * 1024;
    {
      struct StepIn { f32x4 r0, r1, w0, w1, d0, d1, k0, k1, b0, b1; f32x2 v; };
      auto ldstep = [&](int st) -> StepIn {
        StepIn x;
        const float* q = cur + st * 64 + sub * 8;
        x.k0 = *(const f32x4*)(q + 4096); x.k1 = *(const f32x4*)(q + 4096 + 4);
        x.v = *(const f32x2*)(cur + 3072 + st * 64 + 2 * rp);
        x.d0 = *(const f32x4*)(q + 2048); x.d1 = *(const f32x4*)(q + 2048 + 4);
        x.b0 = *(const f32x4*)(q + 5120); x.b1 = *(const f32x4*)(q + 5120 + 4);
        x.w0 = *(const f32x4*)(q + 1024); x.w1 = *(const f32x4*)(q + 1024 + 4);
        x.r0 = *(const f32x4*)(q); x.r1 = *(const f32x4*)(q + 4);
        return x;
      };
      f32x2 ypend = {0.f, 0.f};
      auto dostep = [&](const StepIn& x, int st) {
        const float rr[8] = {x.r0[0], x.r0[1], x.r0[2], x.r0[3], x.r1[0], x.r1[1], x.r1[2], x.r1[3]};
        const float ww[8] = {x.w0[0], x.w0[1], x.w0[2], x.w0[3], x.w1[0], x.w1[1], x.w1[2], x.w1[3]};
        const float dd[8] = {x.d0[0], x.d0[1], x.d0[2], x.d0[3], x.d1[0], x.d1[1], x.d1[2], x.d1[3]};
        const float kk[8] = {x.k0[0], x.k0[1], x.k0[2], x.k0[3], x.k1[0], x.k1[1], x.k1[2], x.k1[3]};
        const float bb[8] = {x.b0[0], x.b0[1], x.b0[2], x.b0[3], x.b1[0], x.b1[1], x.b1[2], x.b1[3]};
        f32x2 sa0 = S[0] * kk[0], sa1 = S[1] * kk[1];
#pragma unroll
        for (int j = 2; j < 8; j += 2) { sa0 += S[j] * kk[j]; sa1 += S[j + 1] * kk[j + 1]; }
        f32x2 sa = sa0 + sa1;
        if (st > 0) {
          f32x2 yp = ypend;
          yp.x = red8(yp.x); yp.y = red8(yp.y);
          if (sub == 0) *(f32x2*)(yb + (st - 1) * 64 + 2 * rp) = yp;
        }
        sa.x = red8(sa.x); sa.y = red8(sa.y);
        f32x2 y0 = {0.f, 0.f}, y1 = {0.f, 0.f};
#pragma unroll
        for (int j = 0; j < 8; j += 2) {
          const f32x2 t0 = x.v * dd[j] - sa * bb[j], t1 = x.v * dd[j + 1] - sa * bb[j + 1];
          S[j] = S[j] * ww[j] + t0; S[j + 1] = S[j + 1] * ww[j + 1] + t1;
          y0 += S[j] * rr[j]; y1 += S[j + 1] * rr[j + 1];
        }
        ypend = y0 + y1;
      };
      StepIn xa = ldstep(0), xb;
#pragma unroll
      for (int s2 = 0; s2 < 16; s2 += 2) {
        xb = ldstep(s2 + 1);
        dostep(xa, s2);
        if (s2 + 2 < 16) xa = ldstep(s2 + 2);
        dostep(xb, s2 + 1);
      }
      {
        f32x2 yp = ypend;
        yp.x = red8(yp.x); yp.y = red8(yp.y);
        if (sub == 0) *(f32x2*)(yb + 15 * 64 + 2 * rp) = yp;
      }
    }
    if (c + 1 < 144) stage((c + 1) & 1);
    __syncthreads();
    {
      const f32x4 y4 = *(const f32x4*)(yb + ls * 64 + lc);
      *(GL u32x2*)(ald + (size_t)rowof(c * 16 + ls) * 512 + hd * 64 + lc) = pk4(y4);
    }
  }
  __syncthreads();
}

__device__ __forceinline__ void ph_rwkv_post(const Params& p, int e, const bf16_t* zr, const bf16_t* alr, const bf16_t* g, bf16_t* mix) {
  const int tidq = tid_(); const int gdq = gdim_(); const int bidq = bid_(); (void)gdq; (void)bidq;
  OPQ(zr); OPQ(alr); OPQ(g); OPQ(mix);
  const int lane = tidq & 63, c = lane * 8;
  float lw[8], lb[8], rk[8];
#pragma unroll
  for (int i = 0; i < 8; ++i) { lw[i] = p.rw_ln_w[e * 512 + c + i]; lb[i] = p.rw_ln_b[e * 512 + c + i]; rk[i] = p.rw_r_k[e * 512 + c + i]; }
  constexpr int R = 2;
  const int nw = gdq * 4;
  for (int row0 = bidq * 4 + (tidq >> 6); row0 < MT; row0 += nw * R) {
    u32x4 u0[R], u1[R], ur[R], uk[R], uv[R], ug[R];
#pragma unroll
    for (int j = 0; j < R; ++j) {
      const int row = row0 + j * nw;
      if (row < MT) {
        u0[j] = *(const GL u32x4*)(alr + (size_t)row * 512 + c);
        u1[j] = *(const GL u32x4*)(alr + ((size_t)MT + row) * 512 + c);
        ur[j] = *(const GL u32x4*)(zr + (size_t)row * 1536 + c);
        uk[j] = *(const GL u32x4*)(zr + (size_t)row * 1536 + 512 + c);
        uv[j] = *(const GL u32x4*)(zr + (size_t)row * 1536 + 1024 + c);
        ug[j] = *(const GL u32x4*)(g + (size_t)row * 512 + c);
      }
    }
#pragma unroll
    for (int j = 0; j < R; ++j) {
      const int row = row0 + j * nw;
      if (row < MT) {
        float y[8], y1[8], r[8], k[8], v[8], gg[8], o[8];
        unpack8(u0[j], y); unpack8(u1[j], y1); unpack8(ur[j], r); unpack8(uk[j], k); unpack8(uv[j], v); unpack8(ug[j], gg);
        float sm = 0.f, bs = 0.f;
#pragma unroll
        for (int i = 0; i < 8; ++i) { y[i] += y1[i]; sm += y[i]; bs += r[i] * k[i] * rk[i]; }
        sm += __shfl_xor(sm, 1); sm += __shfl_xor(sm, 2); sm += __shfl_xor(sm, 4);
        bs += __shfl_xor(bs, 1); bs += __shfl_xor(bs, 2); bs += __shfl_xor(bs, 4);
        const float mean = sm * (1.f / 64.f);
        float vs = 0.f;
#pragma unroll
        for (int i = 0; i < 8; ++i) { y[i] -= mean; vs += y[i] * y[i]; }
        vs += __shfl_xor(vs, 1); vs += __shfl_xor(vs, 2); vs += __shfl_xor(vs, 4);
        const float rstd = rsqrtf(vs * (1.f / 64.f) + 64e-5f);
#pragma unroll
        for (int i = 0; i < 8; ++i) o[i] = (y[i] * rstd * lw[i] + lb[i] + bs * v[i]) * gg[i];
        *(GL u32x4*)(mix + (size_t)row * 1024 + 512 + c) = pack8(o);
      }
    }
  }
}

__device__ __forceinline__ void ph_conv(const Params& p, int o, const bf16_t* zo, bf16_t* uc) {
  const int tidq = tid_(); const int gdq = gdim_(); const int bidq = bid_(); (void)gdq; (void)bidq;
  OPQ(zo); OPQ(uc);
  const int lane = tidq & 63, c = lane * 8;
  float cw[4][8], cb[8];
#pragma unroll
  for (int j = 0; j < 4; ++j)
#pragma unroll
    for (int i = 0; i < 8; ++i) cw[j][i] = p.lru_conv_w[(o * 4 + j) * 512 + c + i];
#pragma unroll
  for (int i = 0; i < 8; ++i) cb[i] = p.lru_conv_b[o * 512 + c + i];
  constexpr int R = 2;
  const int nw = gdq * 4;
  for (int row0 = bidq * 4 + (tidq >> 6); row0 < MT; row0 += nw * R) {
    u32x4 ux[R][4];
#pragma unroll
    for (int r = 0; r < R; ++r) {
      const int row = row0 + r * nw;
      if (row < MT) {
        int t, len;
        if (row < ML) { t = row & 2047; len = 2048; } else { t = (row - ML) & 255; len = 256; }
#pragma unroll
        for (int j = 0; j < 4; ++j) {
          const int tt = t - 1 + j;
          ux[r][j] = (u32x4){0u, 0u, 0u, 0u};
          if (tt >= 0 && tt < len) ux[r][j] = *(const GL u32x4*)(zo + (size_t)(row - 1 + j) * 2560 + c);
        }
      }
    }
#pragma unroll
    for (int r = 0; r < R; ++r) {
      const int row = row0 + r * nw;
      if (row < MT) {
        float acc[8];
#pragma unroll
        for (int i = 0; i < 8; ++i) acc[i] = cb[i];
#pragma unroll
        for (int j = 0; j < 4; ++j) {
          float x[8];
          unpack8(ux[r][j], x);
#pragma unroll
          for (int i = 0; i < 8; ++i) acc[i] += cw[j][i] * x[i];
        }
        *(GL u32x4*)(uc + (size_t)row * 512 + c) = pack8(acc);
      }
    }
  }
}

__device__ __forceinline__ void lru_item(const Params& p, int o, int item, const bf16_t* uc, const bf16_t* gates, bf16_t* hd, char* smem) {
  const int tidq = tid_(); const int gdq = gdim_(); const int bidq = bid_(); (void)gdq; (void)bidq;
  OPQ(uc); OPQ(gates); OPQ(hd);
  const int z = item >> 7, b = (item >> 3) & 15, cgp = item & 7;
  const int tid = tidq, c = tid & 63, seg = tid >> 6, ch = cgp * 64 + c;
  bf16_t* st = (bf16_t*)smem + seg * 6144;
  float* segP = (float*)(smem + 49152); float* segH = segP + 256;
  const float lam = p.lru_lambda[(o * 2 + z) * 512 + ch];
  const float kc = -8.f * log1pf(expf(-lam));
  float carry = 0.f;
  __syncthreads();
  for (int sc = 0; sc < 9; ++sc) {
    const int g0 = sc * 256 + seg * 64;
    int rbase; const int rstep = z ? -1 : 1;
    if (sc == 0) rbase = ML + b * 256 + (z ? 255 - g0 : g0);
    else { const int gl = g0 - 256; rbase = b * 2048 + (z ? 2047 - gl : gl); }
    float P = 1.f, H = 0.f, hin = 0.f;
#pragma unroll 1
    for (int pass = 0; pass < 2; ++pass) {
      if (pass == 1) H = hin;
#pragma unroll 1
      for (int half = 0; half < 2; ++half) {
        u32x4 lr[4], li[4], lu[4];
#pragma unroll
        for (int j = 0; j < 4; ++j) {
          const int q = c + 64 * j, stp = q >> 3, part = q & 7;
          const size_t row = (size_t)(rbase + rstep * (half * 32 + stp));
          const bf16_t* gp = gates + row * 2048 + z * 1024 + cgp * 64 + part * 8;
          lr[j] = *(const GL u32x4*)gp; li[j] = *(const GL u32x4*)(gp + 512);
          lu[j] = *(const GL u32x4*)(uc + row * 512 + cgp * 64 + part * 8);
        }
        __syncthreads();
#pragma unroll
        for (int j = 0; j < 4; ++j) {
          const int q = c + 64 * j;
          *(u32x4*)(st + q * 8) = lr[j]; *(u32x4*)(st + 2048 + q * 8) = li[j]; *(u32x4*)(st + 4096 + q * 8) = lu[j];
        }
        __syncthreads();
#pragma unroll 8
        for (int i = 0; i < 32; ++i) {
          const float rg = bf2f(st[i * 64 + c]), ig = bf2f(st[2048 + i * 64 + c]), u = bf2f(st[4096 + i * 64 + c]);
          const float la = kc * rg, a = __expf(la);
          const float t2 = 2.f * la;
          const float om = (t2 > -0.02f) ? -t2 * (1.f + t2 * (0.5f + t2 * 0.16666667f)) : 1.f - a * a;
          const float x = __builtin_amdgcn_sqrtf(fmaxf(om, 0.f)) * ig * u;
          H = a * H + x;
          if (pass == 0) P *= a;
          else hd[((size_t)z * MT + (size_t)(rbase + rstep * (half * 32 + i))) * 512 + ch] = f2bf(H);
        }
      }
      if (pass == 0) {
        segP[seg * 64 + c] = P; segH[seg * 64 + c] = H;
        __syncthreads();
        float h = carry;
#pragma unroll
        for (int s2 = 0; s2 < 4; ++s2) { if (s2 == seg) hin = h; h = segP[s2 * 64 + c] * h + segH[s2 * 64 + c]; }
        carry = h;
      }
    }
    __syncthreads();
  }
}
__device__ __forceinline__ void ph_lru_post(const bf16_t* hd, bf16_t* zo) {
  const int tidq = tid_(); const int gdq = gdim_(); const int bidq = bid_(); (void)gdq; (void)bidq;
  OPQ(hd); OPQ(zo);
  const int lane = tidq & 63, c = lane * 8;
  constexpr int R = 4;
  const int nw = gdq * 4;
  for (int row0 = bidq * 4 + (tidq >> 6); row0 < MT; row0 += nw * R) {
    u32x4 ua[R], ub[R], ug[R];
#pragma unroll
    for (int j = 0; j < R; ++j) {
      const int row = row0 + j * nw;
      if (row < MT) {
        ua[j] = *(const GL u32x4*)(hd + (size_t)row * 512 + c);
        ub[j] = *(const GL u32x4*)(hd + ((size_t)MT + row) * 512 + c);
        ug[j] = *(const GL u32x4*)(zo + (size_t)row * 2560 + 512 + c);
      }
    }
#pragma unroll
    for (int j = 0; j < R; ++j) {
      const int row = row0 + j * nw;
      if (row < MT) {
        float a[8], b2[8], g[8], o[8];
        unpack8(ua[j], a); unpack8(ub[j], b2); unpack8(ug[j], g);
#pragma unroll
        for (int i = 0; i < 8; ++i) {
          const float x = g[i];
          const float ge = 0.5f * x * (1.f + tanhf(0.7978845608028654f * (x + 0.044715f * x * x * x)));
          o[i] = (a[i] + b2[i]) * ge;
        }
        *(GL u32x4*)(zo + (size_t)row * 2560 + c) = pack8(o);
      }
    }
  }
}

__device__ __forceinline__ void attn_item(const Params& p, int o, int item, int local, bf16_t* zo, char* smem) {
  const int tidq = tid_(); const int gdq = gdim_(); const int bidq = bid_(); (void)gdq; (void)bidq;
  OPQ(zo);
  const int tid = tidq, lane = tid & 63, w = tid >> 6, fr = lane & 15, fq = lane >> 4;
  constexpr int VS = 524;
  bf16_t* Vt = (bf16_t*)smem;
  float* rpbs = (float*)(smem + 67072);
  int h, b, r = 0, r0 = 0, qrow, qcol = 0, band0 = 0;
  if (local) {
    h = item & 7; r = (item >> 3) & 31; b = item >> 8;
    r0 = min(max(r - 4, 0), 24);
    qcol = w * 16 + fr;
    band0 = min(max(w * 16 - 8, 0), 32);
    qrow = b * 2048 + r * 64 + qcol;
  } else {
    h = item & 7; b = (item >> 3) & 15;
    const int g4 = item >> 7;
    qrow = ML + b * 256 + g4 * 64 + w * 16 + fr;
  }
  const bf16_t* qp = zo + (size_t)qrow * 2560 + 1024 + h * 64;
  const bf16x8 qf0 = *(const GL bf16x8*)(qp + fq * 8), qf1 = *(const GL bf16x8*)(qp + 32 + fq * 8);
  float m1 = -1e30f, lsum = 0.f;
  f32x4 O[4];
#pragma unroll
  for (int i = 0; i < 4; ++i) O[i] = (f32x4){0.f, 0.f, 0.f, 0.f};
  __syncthreads();
  if (local) {
#pragma unroll 4
    for (int i = 0; i < 16; ++i) {
      const int idx = tid + 256 * i, tok = (idx & 7) + 8 * (idx >> 6), e8 = ((idx >> 3) & 7) * 8;
      const int row = b * 2048 + (r0 + (tok >> 6)) * 64 + (tok & 63);
      const u32x4 v = *(const GL u32x4*)(zo + (size_t)row * 2560 + 2048 + h * 64 + e8);
      const unsigned uu[4] = {v.x, v.y, v.z, v.w};
#pragma unroll
      for (int j = 0; j < 4; ++j) { Vt[(e8 + 2 * j) * VS + tok] = (bf16_t)(uu[j] & 0xffffu); Vt[(e8 + 2 * j + 1) * VS + tok] = (bf16_t)(uu[j] >> 16); }
    }
    for (int i = tid; i < 465; i += 256) rpbs[i] = p.na_rpb[(size_t)(o * 8 + h) * 465 + i];
    __syncthreads();
    f32x4 sc[16];
    const int win0 = min(max(qcol - 8, 0), 48);
    float mx = -1e30f;
#pragma unroll
    for (int ni = 0; ni < 16; ++ni) {
      const int kr = ni >> 1, j0 = (ni & 1) * 16;
      const bf16_t* kp = zo + (size_t)(b * 2048 + (r0 + kr) * 64 + band0 + j0 + fr) * 2560 + 1536 + h * 64;
      const bf16x8 k0 = *(const GL bf16x8*)(kp + fq * 8), k1 = *(const GL bf16x8*)(kp + 32 + fq * 8);
      f32x4 s = {0.f, 0.f, 0.f, 0.f};
      s = mfma16(k0, qf0, s); s = mfma16(k1, qf1, s);
      const int drow = r0 + kr - r + 7;
#pragma unroll
      for (int j = 0; j < 4; ++j) {
        const int kcol = band0 + j0 + fq * 4 + j;
        const int rel = kcol - win0;
        const int dcol = min(max(kcol - qcol + 15, 0), 30);
        const float val = (rel >= 0 && rel < 16) ? s[j] * 0.125f + rpbs[drow * 31 + dcol] : -1e30f;
        s[j] = val; mx = fmaxf(mx, val);
      }
      sc[ni] = s;
    }
    mx = fmaxf(mx, __shfl_xor(mx, 16)); mx = fmaxf(mx, __shfl_xor(mx, 32));
    m1 = mx;
#pragma unroll
    for (int a = 0; a < 8; ++a) {
      f32x4 p0, p1;
#pragma unroll
      for (int j = 0; j < 4; ++j) { p0[j] = __expf(sc[2 * a][j] - m1); p1[j] = __expf(sc[2 * a + 1][j] - m1); lsum += p0[j] + p1[j]; }
      const u32x2 a0 = pk4(p0), a1 = pk4(p1);
      const u32x4 pu = {a0.x, a0.y, a1.x, a1.y};
      const bf16x8 pf = *(const bf16x8*)&pu;
#pragma unroll
      for (int ne = 0; ne < 4; ++ne) {
        const bf16_t* vp = Vt + (ne * 16 + fr) * VS + a * 64 + band0 + fq * 4;
        const u32x2 lo = *(const u32x2*)vp, hi = *(const u32x2*)(vp + 16);
        const u32x4 vu = {lo.x, lo.y, hi.x, hi.y};
        O[ne] = mfma16(*(const bf16x8*)&vu, pf, O[ne]);
      }
    }
    __syncthreads();
  }
#pragma unroll 4
  for (int i = 0; i < 8; ++i) {
    const int idx = tid + 256 * i, tok = (idx & 7) + 8 * (idx >> 6), e8 = ((idx >> 3) & 7) * 8;
    const u32x4 v = *(const GL u32x4*)(zo + (size_t)(ML + b * 256 + tok) * 2560 + 2048 + h * 64 + e8);
    const unsigned uu[4] = {v.x, v.y, v.z, v.w};
#pragma unroll
    for (int j = 0; j < 4; ++j) { Vt[(e8 + 2 * j) * VS + tok] = (bf16_t)(uu[j] & 0xffffu); Vt[(e8 + 2 * j + 1) * VS + tok] = (bf16_t)(uu[j] >> 16); }
  }
  __syncthreads();
  {
    f32x4 sc[16];
    float mx = -1e30f;
#pragma unroll
    for (int ni = 0; ni < 16; ++ni) {
      const bf16_t* kp = zo + (size_t)(ML + b * 256 + ni * 16 + fr) * 2560 + 1536 + h * 64;
      const bf16x8 k0 = *(const GL bf16x8*)(kp + fq * 8), k1 = *(const GL bf16x8*)(kp + 32 + fq * 8);
      f32x4 s = {0.f, 0.f, 0.f, 0.f};
      s = mfma16(k0, qf0, s); s = mfma16(k1, qf1, s);
#pragma unroll
      for (int j = 0; j < 4; ++j) { s[j] *= 0.125f; mx = fmaxf(mx, s[j]); }
      sc[ni] = s;
    }
    mx = fmaxf(mx, __shfl_xor(mx, 16)); mx = fmaxf(mx, __shfl_xor(mx, 32));
    const float m2 = fmaxf(m1, mx);
    const float alpha = __expf(m1 - m2);
    lsum *= alpha;
#pragma unroll
    for (int ne = 0; ne < 4; ++ne) O[ne] *= alpha;
#pragma unroll
    for (int a = 0; a < 8; ++a) {
      f32x4 p0, p1;
#pragma unroll
      for (int j = 0; j < 4; ++j) { p0[j] = __expf(sc[2 * a][j] - m2); p1[j] = __expf(sc[2 * a + 1][j] - m2); lsum += p0[j] + p1[j]; }
      const u32x2 a0 = pk4(p0), a1 = pk4(p1);
      const u32x4 pu = {a0.x, a0.y, a1.x, a1.y};
      const bf16x8 pf = *(const bf16x8*)&pu;
#pragma unroll
      for (int ne = 0; ne < 4; ++ne) {
        const bf16_t* vp = Vt + (ne * 16 + fr) * VS + a * 32 + fq * 4;
        const u32x2 lo = *(const u32x2*)vp, hi = *(const u32x2*)(vp + 16);
        const u32x4 vu = {lo.x, lo.y, hi.x, hi.y};
        O[ne] = mfma16(*(const bf16x8*)&vu, pf, O[ne]);
      }
    }
  }
  lsum += __shfl_xor(lsum, 16); lsum += __shfl_xor(lsum, 32);
  const float inv = 1.f / lsum;
  bf16_t* op = zo + (size_t)qrow * 2560 + 1024 + h * 64 + fq * 4;
#pragma unroll
  for (int ne = 0; ne < 4; ++ne) *(GL u32x2*)(op + ne * 16) = pk4(O[ne] * inv);
  __syncthreads();
}


#define XB_TMO      128
#define XB_XCNT(j)  (256  + 64 * (j))
#define XB_XSUB(j)  (1280 + 64 * (j))
#define XB_XGEN(j)  (2304 + 64 * (j))
#define XB_TOP      3328
#define XB_TOPGEN   3392
#define XCD_BAR_WORDS 3456
#define XB_SPIN_CAP (1u << 18)
#define LAS __attribute__((address_space(3)))
__device__ __forceinline__ unsigned xb_ld(unsigned* p)              { return __hip_atomic_load(p, __ATOMIC_RELAXED, __HIP_MEMORY_SCOPE_AGENT); }
__device__ __forceinline__ unsigned xb_add(unsigned* p, unsigned v) { return __hip_atomic_fetch_add(p, v, __ATOMIC_RELAXED, __HIP_MEMORY_SCOPE_AGENT); }
__device__ __forceinline__ unsigned xb_xcc_id() { return (unsigned)__builtin_amdgcn_s_getreg((3 << 11) | 20) & 0xFu; }
#define XB_SPIN(cond, bar) do { unsigned _sp = 0; while (cond) { __builtin_amdgcn_s_sleep(1); \
    if ((++_sp & 255u) == 0u) { if (xb_ld(&(bar)[XB_TMO])) break; if (_sp > XB_SPIN_CAP) { atomicAdd(&(bar)[XB_TMO], 1u); break; } } } } while (0)
struct XcdBarrier { unsigned* bar; unsigned x; volatile LAS unsigned* st; };
__device__ __forceinline__ XcdBarrier xcd_barrier_post(unsigned* bar, volatile LAS unsigned* st) {
  XcdBarrier b; b.bar = bar; b.x = xb_xcc_id(); b.st = st;
  if (threadIdx.x == 0) (void)xb_add(&bar[XB_XCNT(b.x)], 1u);
  return b;
}
__device__ __forceinline__ void xcd_barrier_complete(unsigned* bar, unsigned x, unsigned& nloc, unsigned& nx) {
  const unsigned G = gridDim.x * gridDim.y * gridDim.z;
  unsigned sum, cnt, mine, sp = 0u;
  for (;;) {
    sum = 0u; cnt = 0u; mine = 0u;
#pragma unroll
    for (unsigned j = 0; j < 16; ++j) { const unsigned c = xb_ld(&bar[XB_XCNT(j)]); sum += c; cnt += (c > 0u) ? 1u : 0u; mine = (j == x) ? c : mine; }
    if (sum == G) break;
    __builtin_amdgcn_s_sleep(1);
    if ((++sp & 255u) == 0u) { if (xb_ld(&bar[XB_TMO])) break; if (sp > XB_SPIN_CAP) { atomicAdd(&bar[XB_TMO], 1u); break; } }
  }
  nloc = mine > 0u ? mine : 1u; nx = cnt > 0u ? cnt : 1u;
}
__device__ __forceinline__ void xcd_barrier(const XcdBarrier& b) {
  asm volatile("s_waitcnt vmcnt(0)" ::: "memory");
  __syncthreads();
  if (threadIdx.x == 0) {
    unsigned* bar = b.bar;
    __builtin_amdgcn_s_waitcnt(0);
    unsigned nloc = b.st[0], nx = b.st[1];
    if (nloc == 0u) { xcd_barrier_complete(bar, b.x, nloc, nx); b.st[0] = nloc; b.st[1] = nx; }
    const unsigned old = xb_add(&bar[XB_XSUB(b.x)], 1u);
    const unsigned gen = old / nloc;
    if (old + 1u == (gen + 1u) * nloc) {
      __builtin_amdgcn_fence(__ATOMIC_RELEASE, "agent");
      asm volatile("s_waitcnt vmcnt(0)" ::: "memory");
      const unsigned og = xb_add(&bar[XB_TOP], 1u);
      const unsigned tg = og / nx;
      if (og + 1u == (tg + 1u) * nx) xb_add(&bar[XB_TOPGEN], 1u);
      else XB_SPIN(xb_ld(&bar[XB_TOPGEN]) == tg, bar);
      __builtin_amdgcn_fence(__ATOMIC_ACQUIRE, "agent");
      xb_add(&bar[XB_XGEN(b.x)], 1u);
      asm volatile("s_waitcnt vmcnt(0)" ::: "memory");
    } else {
      XB_SPIN(xb_ld(&bar[XB_XGEN(b.x)]) == gen, bar);
      __builtin_amdgcn_fence(__ATOMIC_ACQUIRE, "agent");
      asm volatile("s_waitcnt vmcnt(0)" ::: "memory");
    }
  }
  __syncthreads();
}
#define WSN (opq_(*(char* const volatile*)&p.ws))
#define OUTN (opq_(*(float* const volatile*)&p.out))
#define XN_ (opq_(*(const float* const volatile*)&p.x))
#define CTXN_ (opq_(*(const float* const volatile*)&p.ctx))
#define B_mod ((float*)(WSN + OFF_MOD))
#define B_gates ((float*)(WSN + OFF_GATES))
#define B_WTIN ((const bf16_t*)(WSN + OFF_WTIN))
#define B_WTOUT ((const bf16_t*)(WSN + OFF_WTOUT))
#define B_WT1 ((const bf16_t*)(WSN + OFF_WT1))
#define B_WT2 ((const bf16_t*)(WSN + OFF_WT2))
#define B_xn ((bf16_t*)(WSN + OFF_ARENA))
#define B_zm ((bf16_t*)(WSN + OFF_ARENA + 2 * SU))
#define B_zw ((bf16_t*)(WSN + OFF_ARENA + 6 * SU))
#define B_mix ((bf16_t*)(WSN + OFF_ARENA + 9 * SU + 3 * (SU / 4)))
#define B_hm ((bf16_t*)(WSN + OFF_ARENA))
#define B_zr ((bf16_t*)(WSN + OFF_ARENA))
#define B_alin ((bf16_t*)(WSN + OFF_ARENA + 3 * SU))
#define B_ldp ((_Float16*)(WSN + OFF_ARENA + 3 * SU + 3 * (SU / 4)))
#define B_alr ((bf16_t*)(WSN + OFF_ARENA + 5 * SU + 3 * (SU / 4)))
#define B_gg ((bf16_t*)(WSN + OFF_ARENA + 7 * SU + 3 * (SU / 4)))
#define B_zo ((bf16_t*)(WSN + OFF_ARENA + 2 * SU))
#define B_uc ((bf16_t*)(WSN + OFF_ARENA + 7 * SU))
#define B_lg ((bf16_t*)(WSN + OFF_ARENA + 8 * SU))
#define B_hd ((bf16_t*)(WSN + OFF_ARENA))
#define B_uh ((bf16_t*)(WSN + OFF_ARENA + 2 * SU))
#define B_AR (WSN + OFF_ARENA)
#define B_ws (WSN)
__global__ void __launch_bounds__(256, 2) mega(Params pk) {
  cg::grid_group grid = cg::this_grid();
  if (blockDim.x == 7) grid.sync();
  __shared__ __attribute__((aligned(16))) char smem[73728];
  __shared__ Params sp_;
  __shared__ uint4 xb_words;
  if (threadIdx.x == 0) { sp_ = pk; xb_words = make_uint4(0u, 0u, 0u, 0u); }
  __syncthreads();
  const Params& p = sp_;
  XcdBarrier xb = xcd_barrier_post((unsigned*)(pk.ws + OFF_BAR), (volatile LAS unsigned*)&xb_words);
  const int NOJ = 1 << 30;

  if (blockIdx.x == 0 && threadIdx.x < 64) ((unsigned*)WSN)[threadIdx.x] = 0u;
  ph_prologue(p, smem);
  GSYNC();
  for (int l = 0; l < 4; ++l) {
    const bool last = (l == 3);
    const int Mrows = last ? ML : MT;
    ph_convert(p, l, smem);
    ph_norm(p, l, 0, MT, B_xn, l == 0);
    GSYNC();
    if (SKIP_EVEN && (l & 1) == 0) {
    } else if ((l & 1) == 0) {
      const int e = l >> 1;
      if (EVMASK & 1) gemm_phase(B_xn, 1024, NOJ, 0, B_WTIN, 1024, MT, 3984, 1024, EpiInEven{B_zm, B_zw, B_gates}, smem);
      GSYNC();
      if (EVMASK & 2) ph_rope(p, B_zm);
      GSYNC();
      if (!SKIP_MLSTM) for (int it = blockIdx.x; it < 256; it += gridDim.x) mlstm_item(p, e, it, B_zm, B_gates, B_hm, smem);
      GSYNC();
      if (EVMASK & 4) ph_mlstm_post(p, e, B_zm, B_hm, B_mix);
      GSYNC();
      if (EVMASK & 8) ph_rwkv_prep(p, e, B_zw, B_zr, B_alin);
      GSYNC();
      gemm_phase_t<4>(B_alin, 384, NOJ, 0, (const bf16_t*)(B_ws + OFF_WUP), 64, MT, 1024, 64, EpiLdV{B_ldp, p.rw_w0 + e * 1024}, smem, 512);
      for (int d = 0; d < 2; ++d)
        gemm_phase(B_alin + 128 + d * 64, 384, NOJ, 0, (const bf16_t*)(B_ws + OFF_AUP) + d * 512 * 64, 64, MT, 512, 64,
                   EpiAlr{B_alr + (size_t)d * MT * 512, p.rw_a0 + (e * 2 + d) * 512}, smem);
      if ((EVMASK & 16)) gemm_phase(B_alin + 256, 384, NOJ, 0, (const bf16_t*)(B_ws + OFF_GUP), 128, MT, 512, 128, EpiStore{B_gg, 512}, smem);
      GSYNC();
      if (!SKIP_RWKV) for (int it = blockIdx.x; it < 256; it += gridDim.x) rwkv_item(p, e, it, B_zr, B_ldp, B_alr, smem);
      GSYNC();
      if (EVMASK & 32) ph_rwkv_post(p, e, B_zr, B_alr, B_gg, B_mix);
      GSYNC();
      if (EVMASK & 64) gemm_phase(B_mix, 1024, NOJ, 0, B_WTOUT, 1024, Mrows, 1024, 1024, EpiResid{OUTN, (float*)(B_ws + OFF_HCTX), B_mod + (size_t)l * 17 * 6144 + 2048, (l == 0 ? XN_ : (const float*)OUTN), (l == 0 ? CTXN_ : (const float*)(B_ws + OFF_HCTX))}, smem);
      GSYNC();
    } else if (!SKIP_ODD) {
      const int o = l >> 1;
      gemm_phase(B_xn, 1024, NOJ, 0, B_WTIN, 1024, MT, 2560, 1024, EpiStore{B_zo, 2560}, smem);
      GSYNC();
      ph_conv(p, o, B_zo, B_uc);
      GSYNC();
      gemm_phase_t<4>(B_uc, 512, NOJ, 0, (const bf16_t*)(B_ws + OFF_GWT), 64, MT, 2048, 64, EpiGates{B_lg, p.lru_gate_b + o * 2048}, smem, 256);
      GSYNC();
      {
        const int n_lru = 256, n_na = 4096, n_ca = last ? 0 : 512;
        __shared__ int s_it;
        unsigned* ctr = (unsigned*)WSN + 16 * o;
        for (;;) {
          __syncthreads();
          if (threadIdx.x == 0) s_it = (int)atomicAdd(ctr, 1u);
          __syncthreads();
          const int it = s_it;
          if (it >= n_lru + n_na + n_ca) break;
          if (it < n_lru) lru_item(p, o, it, B_uc, B_lg, B_hd, smem);
          else if (it < n_lru + n_na) attn_item(p, o, it - n_lru, 1, B_zo, smem);
          else attn_item(p, o, it - n_lru - n_na, 0, B_zo, smem);
        }
      }
      GSYNC();
      ph_lru_post(B_hd, B_zo);
      GSYNC();
      gemm_phase(B_zo, 2560, 512, 512, B_WTOUT, 1024, Mrows, 1024, 1024, EpiResid{OUTN, (float*)(B_ws + OFF_HCTX), B_mod + (size_t)l * 17 * 6144 + 2048, (l == 0 ? XN_ : (const float*)OUTN), (l == 0 ? CTXN_ : (const float*)(B_ws + OFF_HCTX))}, smem);
      GSYNC();
    }
    ph_norm(p, l, 1, Mrows, B_xn);
    GSYNC();
    gemm_phase(B_xn, 1024, NOJ, 0, B_WT1, 1024, Mrows, 4096, 1024, EpiMlp1{B_uh}, smem);
    GSYNC();
    gemm_phase(B_uh, 4096, NOJ, 0, B_WT2, 4096, Mrows, 1024, 4096, EpiResid{OUTN, (float*)(B_ws + OFF_HCTX), B_mod + (size_t)l * 17 * 6144 + 5120, (const float*)OUTN, (const float*)(B_ws + OFF_HCTX)}, smem);
    GSYNC();
  }
  ph_final_norm(p);
}

extern "C" void kernel_launch(void* const* d_in, const int* in_sizes, int n_in, void* d_out, int out_size,
                              void* d_ws, size_t ws_size, hipStream_t stream) {
  static int grid_blocks = 0;
  if (!grid_blocks) {
    int dev = 0, cus = 0, per_cu = 0;
    (void)hipGetDevice(&dev);
    (void)hipDeviceGetAttribute(&cus, hipDeviceAttributeMultiprocessorCount, dev);
    (void)hipOccupancyMaxActiveBlocksPerMultiprocessor(&per_cu, mega, 256, 0);
    if (per_cu > 2) per_cu = 2;
    if (per_cu < 1) per_cu = 1;
    grid_blocks = cus * per_cu;
  }
  Params p{};
  const float** pp = (const float**)&p;
  for (int i = 0; i < 31; ++i) pp[i] = (const float*)d_in[i];
  p.out = (float*)d_out;
  p.ws = (char*)d_ws;
  (void)hipMemsetAsync((char*)d_ws + OFF_BAR, 0, 16384, stream);
  void* args[] = {&p};
  hipError_t e = hipLaunchCooperativeKernel((void*)mega, dim3(grid_blocks), dim3(256), args, 0, stream);
  if (e != hipSuccess) fprintf(stderr, "cooperative launch failed: %s (grid %d)\n", hipGetErrorString(e), grid_blocks);
}
```

```cpp
#include <hip/hip_runtime.h>
#include <hip/hip_cooperative_groups.h>
#include <cstdio>
#include <cstdint>
namespace cg = cooperative_groups;
#define GSYNC() xcd_barrier(xb)
#define SKIP_EVEN 0
#define EVMASK 127
#define SKIP_ODD 0
#define SKIP_RWKV 0
#define SKIP_MLSTM 0

typedef unsigned short bf16_t;
typedef short bf16x8 __attribute__((ext_vector_type(8)));
typedef float f32x4 __attribute__((ext_vector_type(4)));
typedef float f32x2 __attribute__((ext_vector_type(2)));
typedef unsigned u32x4 __attribute__((ext_vector_type(4)));
typedef unsigned u32x2 __attribute__((ext_vector_type(2)));
#define GL __attribute__((address_space(1)))

constexpr int ML = 32768, MC = 4096, MT = ML + MC;
constexpr size_t SU = 37748736ull;
constexpr size_t OFF_HCTX = 4096;
constexpr size_t OFF_MOD = OFF_HCTX + 16777216ull;
constexpr size_t OFF_ROPEC = OFF_MOD + 1671168ull;
constexpr size_t OFF_ROPES = OFF_ROPEC + 524288ull;
constexpr size_t OFF_GATES = OFF_ROPES + 524288ull;
constexpr size_t OFF_WTIN = OFF_GATES + 2359296ull;
constexpr size_t OFF_WTOUT = OFF_WTIN + 8388608ull;
constexpr size_t OFF_WT1 = OFF_WTOUT + 2097152ull;
constexpr size_t OFF_WT2 = OFF_WT1 + 8388608ull;
constexpr size_t OFF_WUP = OFF_WT2 + 8388608ull;
constexpr size_t OFF_AUP = OFF_WUP + 131072ull;
constexpr size_t OFF_GUP = OFF_AUP + 131072ull;
constexpr size_t OFF_GWT = OFF_GUP + 131072ull;
constexpr size_t OFF_BAR = OFF_GWT + 262144ull;
constexpr size_t OFF_ARENA = 50331648ull;
static_assert(OFF_BAR + 16384ull <= OFF_ARENA, "persistent region overflow");

struct Params {
  const float *x, *c, *ctx, *c_ctx, *ada_w, *ada_b, *mix_out_w, *mlp_w1, *mlp_w2, *ev_in_w, *ml_gate_b, *ml_norm_w,
      *rw_mu, *rw_w0, *rw_w_up, *rw_a0, *rw_a_up, *rw_g_up, *rw_k_k, *rw_k_a, *rw_r_k, *rw_ln_w, *rw_ln_b, *od_in_w,
      *lru_conv_w, *lru_conv_b, *lru_gate_w, *lru_gate_b, *lru_lambda, *na_rpb, *final_norm_w;
  float* out;
  char* ws;
};

__device__ __forceinline__ float bf2f(unsigned h) { return __uint_as_float(h << 16); }
__device__ __forceinline__ float bflo(unsigned u) { return __uint_as_float(u << 16); }
__device__ __forceinline__ float bfhi(unsigned u) { return __uint_as_float(u & 0xffff0000u); }
typedef __bf16 bf16x2_t __attribute__((ext_vector_type(2)));
__device__ __forceinline__ unsigned pk2(float lo, float hi) {
  f32x2 v = {lo, hi};
  bf16x2_t b = __builtin_convertvector(v, bf16x2_t);
  return __builtin_bit_cast(unsigned, b);
}
__device__ __forceinline__ bf16_t f2bf(float f) { return (bf16_t)(pk2(f, 0.f) & 0xffffu); }
__device__ __forceinline__ u32x2 pk4(f32x4 v) { u32x2 r; r.x = pk2(v[0], v[1]); r.y = pk2(v[2], v[3]); return r; }
__device__ __forceinline__ void unpack8(u32x4 u, float* f) {
  f[0] = bflo(u.x); f[1] = bfhi(u.x); f[2] = bflo(u.y); f[3] = bfhi(u.y);
  f[4] = bflo(u.z); f[5] = bfhi(u.z); f[6] = bflo(u.w); f[7] = bfhi(u.w);
}
__device__ __forceinline__ u32x4 pack8(const float* f) {
  u32x4 r; r.x = pk2(f[0], f[1]); r.y = pk2(f[2], f[3]); r.z = pk2(f[4], f[5]); r.w = pk2(f[6], f[7]); return r;
}
__device__ __forceinline__ float sigm(float x) { return 1.f / (1.f + __expf(-x)); }
__device__ __forceinline__ f32x4 mfma16(bf16x8 a, bf16x8 b, f32x4 c) { return __builtin_amdgcn_mfma_f32_16x16x32_bf16(a, b, c, 0, 0, 0); }
template <class T> __device__ __forceinline__ T* opq_(T* p) {
  unsigned lo = __builtin_amdgcn_readfirstlane((unsigned)(uintptr_t)p);
  unsigned hi = __builtin_amdgcn_readfirstlane((unsigned)((uintptr_t)p >> 32));
  asm volatile("" : "+s"(lo), "+s"(hi));
  return (T*)(((uintptr_t)hi << 32) | (uintptr_t)lo);
}
#define OPQ(x) x = opq_(x)
__device__ __forceinline__ int tid_() { int t = threadIdx.x; asm volatile("" : "+v"(t)); return t; }
__device__ __forceinline__ int gdim_() { int t = gridDim.x; asm volatile("" : "+s"(t)); return t; }
__device__ __forceinline__ int bid_() { int t = blockIdx.x; asm volatile("" : "+s"(t)); return t; }
__device__ __forceinline__ float* hrow2(float* out, float* hctx, int row) {
  return row < ML ? out + (size_t)row * 1024 : hctx + (size_t)(row - ML) * 1024;
}
__device__ __forceinline__ int mrow_of(int row) { return row < ML ? (row >> 11) : 16; }
template <int CTRL> __device__ __forceinline__ float dppf(float x) {
  return __int_as_float(__builtin_amdgcn_update_dpp(0, __float_as_int(x), CTRL, 0xF, 0xF, true));
}
__device__ __forceinline__ float red8(float x) {
  x += dppf<0xB1>(x); x += dppf<0x4E>(x); x += dppf<0x141>(x); return x;
}
__device__ __forceinline__ float wave_sum(float v) {
#pragma unroll
  for (int o = 32; o > 0; o >>= 1) v += __shfl_xor(v, o);
  return v;
}

__device__ __forceinline__ void convT_tile(const float* src, int N, int k0, int n0, bf16_t* dst, int ldd, float* tile) {
  const int tidq = tid_(); const int gdq = gdim_(); const int bidq = bid_(); (void)gdq; (void)bidq;
  OPQ(src); OPQ(dst);
  const int t = tidq, c4 = (t & 15) * 4, r = t >> 4;
#pragma unroll
  for (int i = 0; i < 4; ++i) {
    const int k = r + 16 * i;
    f32x4 v = {0.f, 0.f, 0.f, 0.f};
    if (n0 + c4 < N) v = *(const GL f32x4*)(src + (size_t)(k0 + k) * N + n0 + c4);
    tile[k * 65 + c4 + 0] = v[0]; tile[k * 65 + c4 + 1] = v[1]; tile[k * 65 + c4 + 2] = v[2]; tile[k * 65 + c4 + 3] = v[3];
  }
  __syncthreads();
  const int n = t >> 2, kq = (t & 3) * 16;
  float f[16];
#pragma unroll
  for (int j = 0; j < 16; ++j) f[j] = tile[(kq + j) * 65 + n];
  bf16_t* d = dst + (size_t)(n0 + n) * ldd + k0 + kq;
  *(GL u32x4*)d = pack8(f);
  *(GL u32x4*)(d + 8) = pack8(f + 8);
  __syncthreads();
}
__device__ __forceinline__ void conv_matrix(const float* src, int K, int N, int Npad, bf16_t* dst, int ldd, float* tile) {
  const int tidq = tid_(); const int gdq = gdim_(); const int bidq = bid_(); (void)gdq; (void)bidq;
  const int ntk = K / 64, ntn = Npad / 64;
  for (int t = bidq; t < ntk * ntn; t += gdq) convT_tile(src, N, (t % ntk) * 64, (t / ntk) * 64, dst, ldd, tile);
}
__device__ __forceinline__ void ph_convert(const Params& p, int l, char* smem) {
  const int tidq = tid_(); const int gdq = gdim_(); const int bidq = bid_(); (void)gdq; (void)bidq;
  float* tile = (float*)smem;
  char* ws = p.ws;
  if ((l & 1) == 0) {
    const int e = l >> 1;
    conv_matrix(p.ev_in_w + (size_t)e * 1024 * 3984, 1024, 3984, 4096, (bf16_t*)(ws + OFF_WTIN), 1024, tile);
    for (int d = 0; d < 2; ++d) {
      conv_matrix(p.rw_w_up + (size_t)(e * 2 + d) * 64 * 512, 64, 512, 512, (bf16_t*)(ws + OFF_WUP) + d * 512 * 64, 64, tile);
      conv_matrix(p.rw_a_up + (size_t)(e * 2 + d) * 64 * 512, 64, 512, 512, (bf16_t*)(ws + OFF_AUP) + d * 512 * 64, 64, tile);
    }
    conv_matrix(p.rw_g_up + (size_t)e * 128 * 512, 128, 512, 512, (bf16_t*)(ws + OFF_GUP), 128, tile);
  } else {
    const int o = l >> 1;
    conv_matrix(p.od_in_w + (size_t)o * 1024 * 2560, 1024, 2560, 2560, (bf16_t*)(ws + OFF_WTIN), 1024, tile);
    for (int t = bidq; t < 32; t += gdq) {
      const int zg = t >> 3, n = t & 7;
      convT_tile(p.lru_gate_w + (size_t)(((o * 4 + zg) * 8 + n)) * 4096, 64, 0, 0, (bf16_t*)(ws + OFF_GWT) + (size_t)n * 256 * 64 + zg * 64 * 64, 64, tile);
    }
  }
  conv_matrix(p.mix_out_w + (size_t)l * 1024 * 1024, 1024, 1024, 1024, (bf16_t*)(ws + OFF_WTOUT), 1024, tile);
  conv_matrix(p.mlp_w1 + (size_t)l * 1024 * 4096, 1024, 4096, 4096, (bf16_t*)(ws + OFF_WT1), 1024, tile);
  conv_matrix(p.mlp_w2 + (size_t)l * 4096 * 1024, 4096, 1024, 1024, (bf16_t*)(ws + OFF_WT2), 4096, tile);
}

__device__ __forceinline__ void ph_prologue(const Params& p, char* smem) {
  const int tidq = tid_(); const int gdq = gdim_(); const int bidq = bid_(); (void)gdq; (void)bidq;
  const int gtid = bidq * 256 + tidq, gsz = gdq * 256;
  {
    float* rc = (float*)(p.ws + OFF_ROPEC); float* rs = (float*)(p.ws + OFF_ROPES);
    for (int i = gtid; i < 2048 * 64; i += gsz) {
      const int t = i >> 6, f = i & 63;
      const float pos = (f < 32) ? (float)(t >> 6) : (float)(t & 63);
      const float inv = powf(10000.0f, -(float)(f & 31) / 32.0f);
      const float ang = pos * inv;
      rc[i] = cosf(ang); rs[i] = sinf(ang);
    }
  }
  float* s = (float*)smem;
  float* mod = (float*)(p.ws + OFF_MOD);
  for (int item = bidq; item < 384; item += gdq) {
    const int l = item / 96, n0 = (item % 96) * 64;
    for (int idx = tidq; idx < 17 * 1024; idx += 256) {
      const int r = idx >> 10, k = idx & 1023;
      const float cv = r < 16 ? p.c[r * 1024 + k] : p.c_ctx[k];
      s[idx] = cv / (1.f + expf(-cv));
    }
    __syncthreads();
    const int kq = tidq >> 6, nn = tidq & 63;
    float acc[17];
#pragma unroll
    for (int r = 0; r < 17; ++r) acc[r] = 0.f;
    const float* wp = p.ada_w + ((size_t)l * 1024 + kq * 256) * 6144 + n0 + nn;
    for (int k = 0; k < 256; k += 4) {
      const float w0 = wp[(size_t)(k + 0) * 6144], w1 = wp[(size_t)(k + 1) * 6144], w2 = wp[(size_t)(k + 2) * 6144], w3 = wp[(size_t)(k + 3) * 6144];
#pragma unroll
      for (int r = 0; r < 17; ++r) {
        const f32x4 sv = *(const f32x4*)(s + r * 1024 + kq * 256 + k);
        acc[r] += sv[0] * w0 + sv[1] * w1 + sv[2] * w2 + sv[3] * w3;
      }
    }
    __syncthreads();
#pragma unroll
    for (int r = 0; r < 17; ++r) s[(kq * 17 + r) * 64 + nn] = acc[r];
    __syncthreads();
    for (int idx = tidq; idx < 17 * 64; idx += 256) {
      const int r = idx >> 6, n = idx & 63;
      float v = p.ada_b[l * 6144 + n0 + n];
#pragma unroll
      for (int q = 0; q < 4; ++q) v += s[(q * 17 + r) * 64 + n];
      mod[((size_t)l * 17 + r) * 6144 + n0 + n] = v;
    }
    __syncthreads();
  }
}

__device__ __forceinline__ void ph_norm(const Params& p, int l, int which, int Mrows, bf16_t* xn, bool from_input = false) {
  const int tidq = tid_(); const int gdq = gdim_(); const int bidq = bid_(); (void)gdq; (void)bidq;
  const int lane = tidq & 63;
  float* out_ = from_input ? (float*)p.x : p.out; char* ws_ = p.ws; OPQ(out_); OPQ(ws_); OPQ(xn);
  float* hctx_ = from_input ? (float*)p.ctx : (float*)(ws_ + OFF_HCTX); OPQ(hctx_);
  const float* mod = (const float*)(ws_ + OFF_MOD) + (size_t)l * 17 * 6144 + which * 3072;
  constexpr int R = 4;
  const int nw = gdq * 4;
  for (int row0 = bidq * 4 + (tidq >> 6); row0 < Mrows; row0 += nw * R) {
    f32x4 v[R][4];
#pragma unroll
    for (int j = 0; j < R; ++j) {
      const int row = row0 + j * nw;
      if (row < Mrows) {
        const float* h = hrow2(out_, hctx_, row);
#pragma unroll
        for (int i = 0; i < 4; ++i) v[j][i] = *(const GL f32x4*)(h + i * 256 + lane * 4);
      }
    }
#pragma unroll
    for (int j = 0; j < R; ++j) {
      const int row = row0 + j * nw;
      if (row < Mrows) {
        float ss = 0.f;
#pragma unroll
        for (int i = 0; i < 4; ++i) ss += v[j][i][0] * v[j][i][0] + v[j][i][1] * v[j][i][1] + v[j][i][2] * v[j][i][2] + v[j][i][3] * v[j][i][3];
        ss = wave_sum(ss);
        const float rstd = rsqrtf(ss * (1.f / 1024.f) + 1e-6f);
        const float* m = mod + (size_t)mrow_of(row) * 6144;
#pragma unroll
        for (int i = 0; i < 4; ++i) {
          const int col = i * 256 + lane * 4;
          const f32x4 sh = *(const GL f32x4*)(m + col), sc = *(const GL f32x4*)(m + 1024 + col);
          f32x4 o = v[j][i] * rstd * (sc + 1.f) + sh;
          *(GL u32x2*)(xn + (size_t)row * 1024 + col) = pk4(o);
        }
      }
    }
  }
}
__device__ __forceinline__ void ph_final_norm(const Params& p) {
  const int tidq = tid_(); const int gdq = gdim_(); const int bidq = bid_(); (void)gdq; (void)bidq;
  const int lane = tidq & 63;
  float* out_ = p.out; OPQ(out_);
  constexpr int R = 4;
  const int nw = gdq * 4;
  for (int row0 = bidq * 4 + (tidq >> 6); row0 < ML; row0 += nw * R) {
    f32x4 v[R][4];
#pragma unroll
    for (int j = 0; j < R; ++j) {
      const int row = row0 + j * nw;
      if (row < ML) {
#pragma unroll
        for (int i = 0; i < 4; ++i) v[j][i] = *(const GL f32x4*)(out_ + (size_t)row * 1024 + i * 256 + lane * 4);
      }
    }
#pragma unroll
    for (int j = 0; j < R; ++j) {
      const int row = row0 + j * nw;
      if (row < ML) {
        float ss = 0.f;
#pragma unroll
        for (int i = 0; i < 4; ++i) ss += v[j][i][0] * v[j][i][0] + v[j][i][1] * v[j][i][1] + v[j][i][2] * v[j][i][2] + v[j][i][3] * v[j][i][3];
        ss = wave_sum(ss);
        const float rstd = rsqrtf(ss * (1.f / 1024.f) + 1e-6f);
#pragma unroll
        for (int i = 0; i < 4; ++i) {
          const int col = i * 256 + lane * 4;
          const f32x4 w = *(const GL f32x4*)(p.final_norm_w + col);
          *(GL f32x4*)(out_ + (size_t)row * 1024 + col) = v[j][i] * rstd * w;
        }
      }
    }
  }
}

template <int MI, class Epi>
__device__ __forceinline__ void gemm_phase_t(const bf16_t* A, int lda, int jump_at, int jump, const bf16_t* Bt, int ldb,
                           int Mrows, int N, int K, Epi epi, char* smem, int a_grp = 0) {
  const int tidq = tid_(); const int gdq = gdim_(); const int bidq = bid_();
  OPQ(A); OPQ(Bt); epi.launder();
  const int tid = tidq, lane = tid & 63, w = tid >> 6, wr = w >> 1, wc = w & 1, fr = lane & 15, fq = lane >> 4;
  constexpr int BM = MI * 32;
  const int ntm = Mrows / BM, ntn = (N + 127) / 128, nk = K / 64;
  char* As = smem;
  char* Bs = As + BM * 128;
  const int lrow = tid >> 3, lc = (tid & 7) * 8;
  const int lsw = ((tid & 7) ^ ((lrow >> 1) & 7)) << 4;
  const int rsw = (fr >> 1) & 7;
  const int xcd = bidq & 7, slot = bidq >> 3, nslot = gdq >> 3;
  const bool xmap = ((ntm & 7) == 0) && ((gdq & 7) == 0);
  const int ntml = ntm >> 3;
  const int tper = xmap ? ntml * ntn : ntm * ntn;
  const int tj0 = xmap ? slot : bidq, tjs = xmap ? nslot : gdq;
  const int BW = (ntn >= 16) ? 4 : 8;
#define TILE_OF(TJ, M0, N0) { int tm_, tn_; \
    if (xmap) { const int band_ = (TJ) / (BW * ntn), rem_ = (TJ) - band_ * BW * ntn; const int rib_ = min(BW, ntml - band_ * BW); \
      tn_ = rem_ / rib_; tm_ = (band_ * BW + (rem_ - tn_ * rib_)) * 8 + xcd; } \
    else { tm_ = (TJ) / ntn; tn_ = (TJ) % ntn; } \
    M0 = tm_ * BM; N0 = tn_ * 128; }
  u32x4 ra[MI], rb[4];
#define GLOAD(AP, BP, KT) { const int k0_ = (KT) * 64 + lc, ka_ = k0_ + (k0_ >= jump_at ? jump : 0); \
      _Pragma("unroll") for (int i = 0; i < MI; ++i) ra[i] = *(const GL u32x4*)((AP) + (size_t)(32 * i) * lda + ka_); \
      _Pragma("unroll") for (int i = 0; i < 4; ++i) rb[i] = *(const GL u32x4*)((BP) + (size_t)(32 * i) * ldb + k0_); }
  if (tj0 < tper) {
    int m0, n0; TILE_OF(tj0, m0, n0);
    GLOAD(A + (size_t)(m0 + lrow) * lda + (a_grp ? (n0 / a_grp) * K : 0), Bt + (size_t)(n0 + lrow) * ldb, 0);
  }
  for (int tj = tj0; tj < tper; tj += tjs) {
    int m0, n0; TILE_OF(tj, m0, n0);
    int m1 = m0, n1 = n0;
    const bool has_next = (tj + tjs) < tper;
    if (has_next) TILE_OF(tj + tjs, m1, n1);
    f32x4 acc[MI][4];
#pragma unroll
    for (int i = 0; i < MI; ++i)
#pragma unroll
      for (int j = 0; j < 4; ++j) acc[i][j] = (f32x4){0.f, 0.f, 0.f, 0.f};
    const bf16_t* Ap = A + (size_t)(m0 + lrow) * lda + (a_grp ? (n0 / a_grp) * K : 0);
    const bf16_t* Bp = Bt + (size_t)(n0 + lrow) * ldb;
    const bf16_t* Ap1 = A + (size_t)(m1 + lrow) * lda + (a_grp ? (n1 / a_grp) * K : 0);
    const bf16_t* Bp1 = Bt + (size_t)(n1 + lrow) * ldb;
    if constexpr (MI > 6) { if (tj != tj0) GLOAD(Ap, Bp, 0); }
    for (int kt = 0; kt < nk; ++kt) {
      __syncthreads();
#pragma unroll
      for (int i = 0; i < MI; ++i) *(u32x4*)(As + (lrow + 32 * i) * 128 + lsw) = ra[i];
#pragma unroll
      for (int i = 0; i < 4; ++i) *(u32x4*)(Bs + (lrow + 32 * i) * 128 + lsw) = rb[i];
      __syncthreads();
      {
        if constexpr (MI <= 6) {
          const bool lastk = (kt + 1 == nk);
          const bf16_t* ap_ = lastk ? Ap1 : Ap;
          const bf16_t* bp_ = lastk ? Bp1 : Bp;
          const int kn_ = lastk ? 0 : kt + 1;
          GLOAD(ap_, bp_, kn_);
        } else {
          GLOAD(Ap, Bp, min(kt + 1, nk - 1));
        }
      }
#pragma unroll
      for (int ks = 0; ks < 2; ++ks) {
        bf16x8 bfr[4];
#pragma unroll
        for (int ni = 0; ni < 4; ++ni) bfr[ni] = *(const bf16x8*)(Bs + (wc * 64 + ni * 16 + fr) * 128 + (((ks * 4 + fq) ^ rsw) << 4));
#pragma unroll
        for (int mi = 0; mi < MI; ++mi) {
          const bf16x8 af = *(const bf16x8*)(As + (wr * (BM / 2) + mi * 16 + fr) * 128 + (((ks * 4 + fq) ^ rsw) << 4));
#pragma unroll
          for (int ni = 0; ni < 4; ++ni) acc[mi][ni] = mfma16(bfr[ni], af, acc[mi][ni]);
        }
      }
    }
#pragma unroll
    for (int mi = 0; mi < MI; ++mi)
#pragma unroll
      for (int ni = 0; ni < 4; ++ni) {
        const int row = m0 + wr * (BM / 2) + mi * 16 + fr, col = n0 + wc * 64 + ni * 16 + fq * 4;
        if (col < N) epi(row, col, acc[mi][ni]);
      }
  }
#undef GLOAD
#undef TILE_OF
}

template <class Epi>
__device__ __forceinline__ void gemm_phase(const bf16_t* A, int lda, int jump_at, int jump, const bf16_t* Bt, int ldb,
                           int Mrows, int N, int K, Epi epi, char* smem) {
  if (N <= 512) gemm_phase_t<4>(A, lda, jump_at, jump, Bt, ldb, Mrows, N, K, epi, smem);
  else if (N == 1024 && Mrows == MT) gemm_phase_t<6>(A, lda, jump_at, jump, Bt, ldb, Mrows, N, K, epi, smem);
  else gemm_phase_t<8>(A, lda, jump_at, jump, Bt, ldb, Mrows, N, K, epi, smem);
}

struct EpiInEven {
  bf16_t* zm; bf16_t* zw; float* gates;
  __device__ __forceinline__ void launder() { OPQ(zm); OPQ(zw); OPQ(gates); }
  __device__ __forceinline__ void operator()(int row, int col, f32x4 v) const {
    if (col < 2048) *(GL u32x2*)(zm + (size_t)row * 2048 + col) = pk4(v);
    else if (col < 2064) *(GL f32x4*)(gates + (size_t)row * 16 + (col - 2048)) = v;
    else *(GL u32x2*)(zw + (size_t)row * 1920 + (col - 2064)) = pk4(v);
  }
};
struct EpiStore {
  bf16_t* o; int ld;
  __device__ __forceinline__ void launder() { OPQ(o); }
  __device__ __forceinline__ void operator()(int row, int col, f32x4 v) const { *(GL u32x2*)(o + (size_t)row * ld + col) = pk4(v); }
};
struct EpiResid {
  float* out; float* hctx; const float* gate; const float* srcl; const float* srcc;
  __device__ __forceinline__ void launder() { OPQ(out); OPQ(hctx); OPQ(gate); OPQ(srcl); OPQ(srcc); }
  __device__ __forceinline__ void operator()(int row, int col, f32x4 v) const {
    float* h = hrow2(out, hctx, row) + col;
    const float* hs = (row < ML ? srcl + (size_t)row * 1024 : srcc + (size_t)(row - ML) * 1024) + col;
    const f32x4 g = *(const GL f32x4*)(gate + (size_t)mrow_of(row) * 6144 + col);
    f32x4 hv = *(const GL f32x4*)hs;
    hv += g * v;
    *(GL f32x4*)h = hv;
  }
};
struct EpiMlp1 {
  bf16_t* u;
  __device__ __forceinline__ void launder() { OPQ(u); }
  __device__ __forceinline__ void operator()(int row, int col, f32x4 v) const {
    f32x4 r;
#pragma unroll
    for (int i = 0; i < 4; ++i) { const float t = fmaxf(v[i], 0.f); r[i] = t * t; }
    *(GL u32x2*)(u + (size_t)row * 4096 + col) = pk4(r);
  }
};
struct EpiLd {
  _Float16* ld; const float* w0;
  __device__ __forceinline__ void launder() { OPQ(ld); OPQ(w0); }
  __device__ __forceinline__ void operator()(int row, int col, f32x4 v) const {
    const f32x4 b = *(const GL f32x4*)(w0 + col);
    _Float16 o[4];
#pragma unroll
    for (int i = 0; i < 4; ++i) o[i] = (_Float16)(-0.60653065971f * sigm(v[i] + b[i]));
    *(GL u32x2*)(ld + (size_t)row * 512 + col) = *(const u32x2*)o;
  }
};
struct EpiAlr {
  bf16_t* alr; const float* a0;
  __device__ __forceinline__ void launder() { OPQ(alr); OPQ(a0); }
  __device__ __forceinline__ void operator()(int row, int col, f32x4 v) const {
    const f32x4 b = *(const GL f32x4*)(a0 + col);
    f32x4 r;
#pragma unroll
    for (int i = 0; i < 4; ++i) r[i] = sigm(v[i] + b[i]);
    *(GL u32x2*)(alr + (size_t)row * 512 + col) = pk4(r);
  }
};
struct EpiGates {
  bf16_t* g; const float* gb;
  __device__ __forceinline__ void launder() { OPQ(g); OPQ(gb); }
  __device__ __forceinline__ void operator()(int row, int colv, f32x4 v) const {
    const int n = colv >> 8, cl = colv & 255;
    const int zg = cl >> 6, d = cl & 63, c = zg * 512 + n * 64 + d;
    const f32x4 b = *(const GL f32x4*)(gb + c);
    f32x4 r;
#pragma unroll
    for (int i = 0; i < 4; ++i) r[i] = sigm(v[i] + b[i]);
    *(GL u32x2*)(g + (size_t)row * 2048 + c) = pk4(r);
  }
};

__device__ __forceinline__ void ph_rope(const Params& p, bf16_t* zm) {
  const int tidq = tid_(); const int gdq = gdim_(); const int bidq = bid_(); (void)gdq; (void)bidq;
  OPQ(zm);
  const int lane = tidq & 63;
  const int part = lane >> 5, head = (lane >> 3) & 3, d = (lane & 7) * 8;
  char* ws_ = p.ws; OPQ(ws_);
  const float* rc = (const float*)(ws_ + OFF_ROPEC); const float* rs = (const float*)(ws_ + OFF_ROPES);
  const float sc = part ? 0.08838834764831845f : 1.f;
  constexpr int R = 4;
  const int nw = gdq * 4;
  for (int row0 = bidq * 4 + (tidq >> 6); row0 < MT; row0 += nw * R) {
    u32x4 a[R], b[R];
    f32x4 c0[R], c1[R], s0[R], s1[R];
#pragma unroll
    for (int j = 0; j < R; ++j) {
      const int row = row0 + j * nw;
      if (row < MT) {
        bf16_t* base = zm + (size_t)row * 2048 + part * 512 + head * 128;
        a[j] = *(const GL u32x4*)(base + d); b[j] = *(const GL u32x4*)(base + 64 + d);
        if (row < ML) {
          const int t = row & 2047;
          c0[j] = *(const GL f32x4*)(rc + t * 64 + d); c1[j] = *(const GL f32x4*)(rc + t * 64 + d + 4);
          s0[j] = *(const GL f32x4*)(rs + t * 64 + d); s1[j] = *(const GL f32x4*)(rs + t * 64 + d + 4);
        }
      }
    }
#pragma unroll
    for (int j = 0; j < R; ++j) {
      const int row = row0 + j * nw;
      if (row < MT) {
        bf16_t* base = zm + (size_t)row * 2048 + part * 512 + head * 128;
        float x1[8], x2[8], o1[8], o2[8];
        unpack8(a[j], x1); unpack8(b[j], x2);
        if (row < ML) {
#pragma unroll
          for (int i = 0; i < 8; ++i) {
            const float c = i < 4 ? c0[j][i & 3] : c1[j][i & 3], s = i < 4 ? s0[j][i & 3] : s1[j][i & 3];
            o1[i] = (x1[i] * c - x2[i] * s) * sc; o2[i] = (x1[i] * s + x2[i] * c) * sc;
          }
        } else {
#pragma unroll
          for (int i = 0; i < 8; ++i) { o1[i] = x1[i] * sc; o2[i] = x2[i] * sc; }
        }
        if (row < ML || part) { *(GL u32x4*)(base + d) = pack8(o1); *(GL u32x4*)(base + 64 + d) = pack8(o2); }
      }
    }
  }
}

__device__ __forceinline__ void mlstm_item(const Params& p, int e, int item, const bf16_t* zm, const float* gates, bf16_t* hm, char* smem) {
  const int tidq = tid_(); const int gdq = gdim_(); const int bidq = bid_(); (void)gdq; (void)bidq;
  OPQ(zm); OPQ(gates); OPQ(hm);
  const int eh = item & 1, hh = (item >> 1) & 3, b = (item >> 3) & 15, dir = item >> 7;
  const int tid = tidq, lane = tid & 63, w = tid >> 6, fr = lane & 15, fq = lane >> 4;
  bf16_t* Vt = (bf16_t*)smem;
  bf16_t* Kt = (bf16_t*)(smem + 11520);
  bf16_t* Kn = (bf16_t*)(smem + 11520);
  bf16_t* Ct = (bf16_t*)(smem + 29952);
  bf16_t* Ps = (bf16_t*)(smem + 51712);
  float* fu = (float*)(smem + 60928);
  float* fM = fu + 64;
  float* fb = fu + 128;
  for (int i = tid; i < 80 * 136 / 2; i += 256) ((unsigned*)Ct)[i] = 0u;
  for (int i = tid; i < 16 * 72; i += 256) Vt[64 * 72 + i] = (i < 72) ? (bf16_t)0x3F80 : (bf16_t)0;
  f32x4 acc[2][5];
#pragma unroll
  for (int i = 0; i < 2; ++i)
#pragma unroll
    for (int j = 0; j < 5; ++j) acc[i][j] = (f32x4){0.f, 0.f, 0.f, 0.f};
  float m = 0.f;
  const float gbi = p.ml_gate_b[e * 16 + dir * 8 + hh], gbf = p.ml_gate_b[e * 16 + dir * 8 + 4 + hh];
  const int tq = 16 * w + fr;
  int rbase = 0, rstep = 1;
  auto setrow = [&](int c) {
    const bool isctx = c < 4;
    const int cc = isctx ? c : c - 4, len = isctx ? 256 : 2048, base = isctx ? ML + b * 256 : b * 2048;
    rbase = dir ? base + len - 1 - cc * 64 : base + cc * 64;
    rstep = dir ? -1 : 1;
  };
#define MROW(pp) (rbase + rstep * (pp))
  u32x4 vv[2], kv[4];
  bf16x8 qfn[4];
  float gli = 0.f, gfr = 0.f;
  auto prefetch = [&](int c) {
    setrow(c);
#pragma unroll
    for (int i = 0; i < 2; ++i) { const int s = lane, e8 = (w * 2 + i) * 8; vv[i] = *(const GL u32x4*)(zm + (size_t)MROW(s) * 2048 + 1024 + hh * 128 + eh * 64 + e8); }
#pragma unroll
    for (int i = 0; i < 4; ++i) { const int s = lane, d8 = (w * 4 + i) * 8; kv[i] = *(const GL u32x4*)(zm + (size_t)MROW(s) * 2048 + 512 + hh * 128 + d8); }
#pragma unroll
    for (int ks = 0; ks < 4; ++ks) qfn[ks] = *(const GL bf16x8*)(zm + (size_t)MROW(tq) * 2048 + hh * 128 + ks * 32 + fq * 8);
    if (w == 0) { const float* g = gates + (size_t)MROW(lane) * 16; gli = g[dir * 4 + hh]; gfr = g[8 + dir * 4 + hh]; }
  };
  prefetch(0);
  __syncthreads();
  for (int c = 0; c < 36; ++c) {
    setrow(c);
    if (w == 0) {
      const float li = gli + gbi;
      const float fraw = gfr + gbf;
      const float lf = fminf(fraw, 0.f) - log1pf(expf(-fabsf(fraw)));
      float bc = lf;
#pragma unroll
      for (int o = 1; o < 64; o <<= 1) { const float t = __shfl_up(bc, o); if (lane >= o) bc += t; }
      const float u = li - bc;
      float pm = u;
#pragma unroll
      for (int o = 1; o < 64; o <<= 1) { const float t = __shfl_up(pm, o); if (lane >= o) pm = fmaxf(pm, t); }
      fu[lane] = u; fM[lane] = fmaxf(m, pm); fb[lane] = bc;
    }
#pragma unroll
    for (int i = 0; i < 2; ++i) {
      const int s = lane, e8 = (w * 2 + i) * 8;
      const unsigned uu[4] = {vv[i].x, vv[i].y, vv[i].z, vv[i].w};
#pragma unroll
      for (int j = 0; j < 4; ++j) { Vt[(e8 + 2 * j) * 72 + s] = (bf16_t)(uu[j] & 0xffffu); Vt[(e8 + 2 * j + 1) * 72 + s] = (bf16_t)(uu[j] >> 16); }
    }
#pragma unroll
    for (int i = 0; i < 4; ++i) { const int s = lane, d8 = (w * 4 + i) * 8; *(u32x4*)(Kn + s * 136 + d8) = kv[i]; }
    bf16x8 qf[4];
#pragma unroll
    for (int ks = 0; ks < 4; ++ks) qf[ks] = qfn[ks];
    __syncthreads();
    const float M63 = fM[63];
    const float Mt = fM[tq];
#pragma unroll
    for (int ni = 0; ni < 4; ++ni) {
      f32x4 sa = {0.f, 0.f, 0.f, 0.f};
#pragma unroll
      for (int ks = 0; ks < 4; ++ks) {
        const bf16x8 kfr = *(const bf16x8*)(Kn + (ni * 16 + fr) * 136 + ks * 32 + fq * 8);
        sa = mfma16(kfr, qf[ks], sa);
      }
      const int s0 = ni * 16 + fq * 4;
      const f32x4 u4 = *(const f32x4*)(fu + s0);
      f32x4 pv;
#pragma unroll
      for (int j = 0; j < 4; ++j) pv[j] = (s0 + j <= tq) ? sa[j] * __expf(u4[j] - Mt) : 0.f;
      *(u32x2*)(Ps + tq * 72 + s0) = pk4(pv);
    }
    __syncthreads();
#pragma unroll
    for (int i = 0; i < 4; ++i) {
      const int s = lane, d8 = (w * 4 + i) * 8;
      const float wk = __expf(fu[s] - M63);
      float kf[8];
      unpack8(kv[i], kf);
#pragma unroll
      for (int j = 0; j < 8; ++j) Kt[(d8 + j) * 72 + s] = f2bf(kf[j] * wk);
    }
    const int orow = MROW(tq);
    if (c + 1 < 36) prefetch(c + 1);
    f32x4 aC[5], aP[5];
#pragma unroll
    for (int ni = 0; ni < 5; ++ni) { aC[ni] = (f32x4){0.f, 0.f, 0.f, 0.f}; aP[ni] = (f32x4){0.f, 0.f, 0.f, 0.f}; }
#pragma unroll
    for (int ni = 0; ni < 5; ++ni)
#pragma unroll
      for (int ks = 0; ks < 4; ++ks) {
        const bf16x8 cf = *(const bf16x8*)(Ct + (ni * 16 + fr) * 136 + ks * 32 + fq * 8);
        aC[ni] = mfma16(cf, qf[ks], aC[ni]);
      }
#pragma unroll
    for (int ks = 0; ks < 2; ++ks) {
      const bf16x8 pf = *(const bf16x8*)(Ps + tq * 72 + ks * 32 + fq * 8);
#pragma unroll
      for (int ni = 0; ni < 5; ++ni) {
        const bf16x8 vf = *(const bf16x8*)(Vt + (ni * 16 + fr) * 72 + ks * 32 + fq * 8);
        aP[ni] = mfma16(vf, pf, aP[ni]);
      }
    }
    {
      const float wprev = __expf(m - Mt);
      const float dval = wprev * aC[4][0] + aP[4][0];
      const float den = __shfl(dval, fr);
      const float dn = fmaxf(fabsf(den), __expf(-(fb[tq] + Mt)));
      const float inv = 1.f / dn;
      bf16_t* ho = hm + ((size_t)dir * MT + orow) * 512 + hh * 128 + eh * 64 + fq * 4;
#pragma unroll
      for (int ni = 0; ni < 4; ++ni) {
        const f32x4 hv = (aC[ni] * wprev + aP[ni]) * inv;
        *(GL u32x2*)(ho + ni * 16) = pk4(hv);
      }
    }
    const float bend = fb[63];
    __syncthreads();
    const float keep = __expf(m - M63);
#pragma unroll
    for (int mi = 0; mi < 2; ++mi)
#pragma unroll
      for (int ni = 0; ni < 5; ++ni) acc[mi][ni] *= keep;
#pragma unroll
    for (int ks = 0; ks < 2; ++ks) {
      bf16x8 vf[5];
#pragma unroll
      for (int ni = 0; ni < 5; ++ni) vf[ni] = *(const bf16x8*)(Vt + (ni * 16 + fr) * 72 + ks * 32 + fq * 8);
#pragma unroll
      for (int mi = 0; mi < 2; ++mi) {
        const bf16x8 kf = *(const bf16x8*)(Kt + (32 * w + mi * 16 + fr) * 72 + ks * 32 + fq * 8);
#pragma unroll
        for (int ni = 0; ni < 5; ++ni) acc[mi][ni] = mfma16(kf, vf[ni], acc[mi][ni]);
      }
    }
#pragma unroll
    for (int mi = 0; mi < 2; ++mi)
#pragma unroll
      for (int ni = 0; ni < 5; ++ni) *(u32x2*)(Ct + (ni * 16 + fr) * 136 + 32 * w + mi * 16 + fq * 4) = pk4(acc[mi][ni]);
    m = bend + M63;
    __syncthreads();
  }
#undef MROW
}

__device__ __forceinline__ void ph_mlstm_post(const Params& p, int e, const bf16_t* zm, const bf16_t* hm, bf16_t* mix) {
  const int tidq = tid_(); const int gdq = gdim_(); const int bidq = bid_(); (void)gdq; (void)bidq;
  OPQ(zm); OPQ(hm); OPQ(mix);
  const int lane = tidq & 63, c = lane * 8;
  float nw_[8];
#pragma unroll
  for (int i = 0; i < 8; ++i) nw_[i] = p.ml_norm_w[e * 512 + c + i];
  constexpr int R = 4;
  const int nw = gdq * 4;
  for (int row0 = bidq * 4 + (tidq >> 6); row0 < MT; row0 += nw * R) {
    u32x4 ua[R], ub[R], uo[R];
#pragma unroll
    for (int j = 0; j < R; ++j) {
      const int row = row0 + j * nw;
      if (row < MT) {
        ua[j] = *(const GL u32x4*)(hm + (size_t)row * 512 + c);
        ub[j] = *(const GL u32x4*)(hm + ((size_t)MT + row) * 512 + c);
        uo[j] = *(const GL u32x4*)(zm + (size_t)row * 2048 + 1536 + c);
      }
    }
#pragma unroll
    for (int j = 0; j < R; ++j) {
      const int row = row0 + j * nw;
      if (row < MT) {
        float a[8], b2[8], og[8], o[8];
        unpack8(ua[j], a); unpack8(ub[j], b2); unpack8(uo[j], og);
        float ss = 0.f;
#pragma unroll
        for (int i = 0; i < 8; ++i) { a[i] += b2[i]; ss += a[i] * a[i]; }
        ss += __shfl_xor(ss, 1); ss += __shfl_xor(ss, 2); ss += __shfl_xor(ss, 4); ss += __shfl_xor(ss, 8);
        const float rstd = rsqrtf(ss * (1.f / 128.f) + 1e-6f);
#pragma unroll
        for (int i = 0; i < 8; ++i) o[i] = a[i] * rstd * nw_[i] * sigm(og[i]);
        *(GL u32x4*)(mix + (size_t)row * 1024 + c) = pack8(o);
      }
    }
  }
}

__device__ __forceinline__ void ph_rwkv_prep(const Params& p, int e, const bf16_t* zw, bf16_t* zr, bf16_t* alin) {
  const int tidq = tid_(); const int gdq = gdim_(); const int bidq = bid_(); (void)gdq; (void)bidq;
  OPQ(zw); OPQ(zr); OPQ(alin);
  const int lane = tidq & 63;
  const float* mu = p.rw_mu + e * 1920;
  const int nw = gdq * 4;
  for (int row = bidq * 4 + (tidq >> 6); row < MT; row += nw) {
    int t, len;
    if (row < ML) { t = row & 2047; len = 2048; } else { t = (row - ML) & 255; len = 256; }
    const bool hp = t > 0, hn = t < len - 1;
    u32x4 uz[4], up[4], un[4];
#pragma unroll
    for (int q = 0; q < 4; ++q) {
      const int vi = lane + 64 * q;
      if (vi < 240) {
        const int col = vi * 8;
        uz[q] = *(const GL u32x4*)(zw + (size_t)row * 1920 + col);
        up[q] = (u32x4){0u, 0u, 0u, 0u}; un[q] = (u32x4){0u, 0u, 0u, 0u};
        if (hp) up[q] = *(const GL u32x4*)(zw + (size_t)(row - 1) * 1920 + col);
        if (hn) un[q] = *(const GL u32x4*)(zw + (size_t)(row + 1) * 1920 + col);
      }
    }
#pragma unroll
    for (int q = 0; q < 4; ++q) {
      const int vi = lane + 64 * q;
      if (vi < 240) {
        const int col = vi * 8;
        float z[8], zp[8], zn[8], o[8];
        unpack8(uz[q], z); unpack8(up[q], zp); unpack8(un[q], zn);
        const f32x4 m0 = *(const GL f32x4*)(mu + col), m1 = *(const GL f32x4*)(mu + col + 4);
#pragma unroll
        for (int i = 0; i < 8; ++i) {
          const float mm = i < 4 ? m0[i & 3] : m1[i & 3];
          float v = z[i] + mm * (0.5f * (zp[i] + zn[i]) - z[i]);
          if (col >= 1536 && col < 1664) v = tanhf(v);
          else if (col >= 1792) v = sigm(v);
          o[i] = v;
        }
        if (col < 1536) *(GL u32x4*)(zr + (size_t)row * 1536 + col) = pack8(o);
        else *(GL u32x4*)(alin + (size_t)row * 384 + (col - 1536)) = pack8(o);
      }
    }
  }
}

__device__ __forceinline__ void rwkv_item(const Params& p, int e, int item, const bf16_t* zr, const _Float16* ldp, bf16_t* alr, char* smem) {
  const int tidq = tid_(); const int gdq = gdim_(); const int bidq = bid_(); (void)gdq; (void)bidq;
  OPQ(zr); OPQ(ldp); OPQ(alr);
  const int dir = item >> 7, b = (item >> 3) & 15, hd = item & 7;
  const int tid = tidq;
  float* buf = (float*)smem;
  float* ybuf = (float*)(smem + 49152);
  const int ls = tid >> 4, lc = (tid & 15) * 4;
  const int rp = tid >> 3, sub = tid & 7;
  const f32x4 kk4 = *(const GL f32x4*)(p.rw_k_k + e * 512 + hd * 64 + lc);
  const f32x4 ka4 = *(const GL f32x4*)(p.rw_k_a + e * 512 + hd * 64 + lc);
  const _Float16* ldd = ldp + (size_t)dir * MT * 512;
  bf16_t* ald = alr + (size_t)dir * MT * 512;
  auto rowof = [&](int g) -> int {
    if (g < 256) return ML + b * 256 + (dir ? 255 - g : g);
    const int gl = g - 256;
    return b * 2048 + (dir ? 2047 - gl : gl);
  };
  u32x2 r4, k4, v4, l4, a4;
  auto gload = [&](int c) {
    const int row = rowof(c * 16 + ls);
    const bf16_t* zp = zr + (size_t)row * 1536 + hd * 64 + lc;
    r4 = *(const GL u32x2*)zp; k4 = *(const GL u32x2*)(zp + 512); v4 = *(const GL u32x2*)(zp + 1024);
    l4 = *(const GL u32x2*)(ldd + (size_t)row * 512 + hd * 64 + lc);
    a4 = *(const GL u32x2*)(ald + (size_t)row * 512 + hd * 64 + lc);
  };
  auto stage = [&](int nb) {
    float* d = buf + nb * 6 * 1024 + ls * 64 + lc;
    const f32x4 r = {bflo(r4.x), bfhi(r4.x), bflo(r4.y), bfhi(r4.y)};
    const f32x4 k = {bflo(k4.x), bfhi(k4.x), bflo(k4.y), bfhi(k4.y)};
    const f32x4 v = {bflo(v4.x), bfhi(v4.x), bflo(v4.y), bfhi(v4.y)};
    const f32x4 a = {bflo(a4.x), bfhi(a4.x), bflo(a4.y), bfhi(a4.y)};
    _Float16 lh[4]; *(u32x2*)lh = l4;
    f32x4 kk = k * kk4;
    float ss = kk[0] * kk[0] + kk[1] * kk[1] + kk[2] * kk[2] + kk[3] * kk[3];
    ss += __shfl_xor(ss, 1); ss += __shfl_xor(ss, 2); ss += __shfl_xor(ss, 4); ss += __shfl_xor(ss, 8);
    const float inv = 1.f / fmaxf(sqrtf(ss), 1e-12f);
    kk = kk * inv;
    f32x4 wv, kd, bv;
#pragma unroll
    for (int i = 0; i < 4; ++i) { wv[i] = __expf((float)lh[i]); kd[i] = k[i] * (1.f + (a[i] - 1.f) * ka4[i]); bv[i] = kk[i] * a[i]; }
    *(f32x4*)(d + 0 * 1024) = r; *(f32x4*)(d + 1 * 1024) = wv; *(f32x4*)(d + 2 * 1024) = kd;
    *(f32x4*)(d + 3 * 1024) = v; *(f32x4*)(d + 4 * 1024) = kk; *(f32x4*)(d + 5 * 1024) = bv;
  };
  f32x2 S[8];
#pragma unroll
  for (int j = 0; j < 8; ++j) S[j] = (f32x2){0.f, 0.f};
  __syncthreads();
  gload(0);
  stage(0);
  __syncthreads();
  for (int c = 0; c < 144; ++c) {
    if (c + 1 < 144) gload(c + 1);
    const float* cur = buf + (c & 1) * 6 * 1024;
    float* yb = ybuf + (c & 1) * 1024;
    {
      struct StepIn { f32x4 r0, r1, w0, w1, d0, d1, k0, k1, b0, b1; f32x2 v; };
      auto ldstep = [&](int st) -> StepIn {
        StepIn x;
        const float* q = cur + st * 64 + sub * 8;
        x.k0 = *(const f32x4*)(q + 4096); x.k1 = *(const f32x4*)(q + 4096 + 4);
        x.v = *(const f32x2*)(cur + 3072 + st * 64 + 2 * rp);
        x.d0 = *(const f32x4*)(q + 2048); x.d1 = *(const f32x4*)(q + 2048 + 4);
        x.b0 = *(const f32x4*)(q + 5120); x.b1 = *(const f32x4*)(q + 5120 + 4);
        x.w0 = *(const f32x4*)(q + 1024); x.w1 = *(const f32x4*)(q + 1024 + 4);
        x.r0 = *(const f32x4*)(q); x.r1 = *(const f32x4*)(q + 4);
        return x;
      };
      f32x2 ypend = {0.f, 0.f};
      auto dostep = [&](const StepIn& x, int st) {
        const float rr[8] = {x.r0[0], x.r0[1], x.r0[2], x.r0[3], x.r1[0], x.r1[1], x.r1[2], x.r1[3]};
        const float ww[8] = {x.w0[0], x.w0[1], x.w0[2], x.w0[3], x.w1[0], x.w1[1], x.w1[2], x.w1[3]};
        const float dd[8] = {x.d0[0], x.d0[1], x.d0[2], x.d0[3], x.d1[0], x.d1[1], x.d1[2], x.d1[3]};
        const float kk[8] = {x.k0[0], x.k0[1], x.k0[2], x.k0[3], x.k1[0], x.k1[1], x.k1[2], x.k1[3]};
        const float bb[8] = {x.b0[0], x.b0[1], x.b0[2], x.b0[3], x.b1[0], x.b1[1], x.b1[2], x.b1[3]};
        f32x2 sa0 = S[0] * kk[0], sa1 = S[1] * kk[1];
#pragma unroll
        for (int j = 2; j < 8; j += 2) { sa0 += S[j] * kk[j]; sa1 += S[j + 1] * kk[j + 1]; }
        f32x2 sa = sa0 + sa1;
        if (st > 0) {
          f32x2 yp = ypend;
          yp.x = red8(yp.x); yp.y = red8(yp.y);
          if (sub == 0) *(f32x2*)(yb + (st - 1) * 64 + 2 * rp) = yp;
        }
        sa.x = red8(sa.x); sa.y = red8(sa.y);
        f32x2 y0 = {0.f, 0.f}, y1 = {0.f, 0.f};
#pragma unroll
        for (int j = 0; j < 8; j += 2) {
          const f32x2 t0 = x.v * dd[j] - sa * bb[j], t1 = x.v * dd[j + 1] - sa * bb[j + 1];
          S[j] = S[j] * ww[j] + t0; S[j + 1] = S[j + 1] * ww[j + 1] + t1;
          y0 += S[j] * rr[j]; y1 += S[j + 1] * rr[j + 1];
        }
        ypend = y0 + y1;
      };
      StepIn xa = ldstep(0), xb;
#pragma unroll
      for (int s2 = 0; s2 < 16; s2 += 2) {
        xb = ldstep(s2 + 1);
        dostep(xa, s2);
        if (s2 + 2 < 16) xa = ldstep(s2 + 2);
        dostep(xb, s2 + 1);
      }
      {
        f32x2 yp = ypend;
        yp.x = red8(yp.x); yp.y = red8(yp.y);
        if (sub == 0) *(f32x2*)(yb + 15 * 64 + 2 * rp) = yp;
      }
    }
    if (c + 1 < 144) stage((c + 1) & 1);
    __syncthreads();
    {
      const f32x4 y4 = *(const f32x4*)(yb + ls * 64 + lc);
      *(GL u32x2*)(ald + (size_t)rowof(c * 16 + ls) * 512 + hd * 64 + lc) = pk4(y4);
    }
  }
  __syncthreads();
}

__device__ __forceinline__ void ph_rwkv_post(const Params& p, int e, const bf16_t* zr, const bf16_t* alr, const bf16_t* g, bf16_t* mix) {
  const int tidq = tid_(); const int gdq = gdim_(); const int bidq = bid_(); (void)gdq; (void)bidq;
  OPQ(zr); OPQ(alr); OPQ(g); OPQ(mix);
  const int lane = tidq & 63, c = lane * 8;
  float lw[8], lb[8], rk[8];
#pragma unroll
  for (int i = 0; i < 8; ++i) { lw[i] = p.rw_ln_w[e * 512 + c + i]; lb[i] = p.rw_ln_b[e * 512 + c + i]; rk[i] = p.rw_r_k[e * 512 + c + i]; }
  constexpr int R = 2;
  const int nw = gdq * 4;
  for (int row0 = bidq * 4 + (tidq >> 6); row0 < MT; row0 += nw * R) {
    u32x4 u0[R], u1[R], ur[R], uk[R], uv[R], ug[R];
#pragma unroll
    for (int j = 0; j < R; ++j) {
      const int row = row0 + j * nw;
      if (row < MT) {
        u0[j] = *(const GL u32x4*)(alr + (size_t)row * 512 + c);
        u1[j] = *(const GL u32x4*)(alr + ((size_t)MT + row) * 512 + c);
        ur[j] = *(const GL u32x4*)(zr + (size_t)row * 1536 + c);
        uk[j] = *(const GL u32x4*)(zr + (size_t)row * 1536 + 512 + c);
        uv[j] = *(const GL u32x4*)(zr + (size_t)row * 1536 + 1024 + c);
        ug[j] = *(const GL u32x4*)(g + (size_t)row * 512 + c);
      }
    }
#pragma unroll
    for (int j = 0; j < R; ++j) {
      const int row = row0 + j * nw;
      if (row < MT) {
        float y[8], y1[8], r[8], k[8], v[8], gg[8], o[8];
        unpack8(u0[j], y); unpack8(u1[j], y1); unpack8(ur[j], r); unpack8(uk[j], k); unpack8(uv[j], v); unpack8(ug[j], gg);
        float sm = 0.f, bs = 0.f;
#pragma unroll
        for (int i = 0; i < 8; ++i) { y[i] += y1[i]; sm += y[i]; bs += r[i] * k[i] * rk[i]; }
        sm += __shfl_xor(sm, 1); sm += __shfl_xor(sm, 2); sm += __shfl_xor(sm, 4);
        bs += __shfl_xor(bs, 1); bs += __shfl_xor(bs, 2); bs += __shfl_xor(bs, 4);
        const float mean = sm * (1.f / 64.f);
        float vs = 0.f;
#pragma unroll
        for (int i = 0; i < 8; ++i) { y[i] -= mean; vs += y[i] * y[i]; }
        vs += __shfl_xor(vs, 1); vs += __shfl_xor(vs, 2); vs += __shfl_xor(vs, 4);
        const float rstd = rsqrtf(vs * (1.f / 64.f) + 64e-5f);
#pragma unroll
        for (int i = 0; i < 8; ++i) o[i] = (y[i] * rstd * lw[i] + lb[i] + bs * v[i]) * gg[i];
        *(GL u32x4*)(mix + (size_t)row * 1024 + 512 + c) = pack8(o);
      }
    }
  }
}

__device__ __forceinline__ void ph_conv(const Params& p, int o, const bf16_t* zo, bf16_t* uc) {
  const int tidq = tid_(); const int gdq = gdim_(); const int bidq = bid_(); (void)gdq; (void)bidq;
  OPQ(zo); OPQ(uc);
  const int lane = tidq & 63, c = lane * 8;
  float cw[4][8], cb[8];
#pragma unroll
  for (int j = 0; j < 4; ++j)
#pragma unroll
    for (int i = 0; i < 8; ++i) cw[j][i] = p.lru_conv_w[(o * 4 + j) * 512 + c + i];
#pragma unroll
  for (int i = 0; i < 8; ++i) cb[i] = p.lru_conv_b[o * 512 + c + i];
  constexpr int R = 2;
  const int nw = gdq * 4;
  for (int row0 = bidq * 4 + (tidq >> 6); row0 < MT; row0 += nw * R) {
    u32x4 ux[R][4];
#pragma unroll
    for (int r = 0; r < R; ++r) {
      const int row = row0 + r * nw;
      if (row < MT) {
        int t, len;
        if (row < ML) { t = row & 2047; len = 2048; } else { t = (row - ML) & 255; len = 256; }
#pragma unroll
        for (int j = 0; j < 4; ++j) {
          const int tt = t - 1 + j;
          ux[r][j] = (u32x4){0u, 0u, 0u, 0u};
          if (tt >= 0 && tt < len) ux[r][j] = *(const GL u32x4*)(zo + (size_t)(row - 1 + j) * 2560 + c);
        }
      }
    }
#pragma unroll
    for (int r = 0; r < R; ++r) {
      const int row = row0 + r * nw;
      if (row < MT) {
        float acc[8];
#pragma unroll
        for (int i = 0; i < 8; ++i) acc[i] = cb[i];
#pragma unroll
        for (int j = 0; j < 4; ++j) {
          float x[8];
          unpack8(ux[r][j], x);
#pragma unroll
          for (int i = 0; i < 8; ++i) acc[i] += cw[j][i] * x[i];
        }
        *(GL u32x4*)(uc + (size_t)row * 512 + c) = pack8(acc);
      }
    }
  }
}

__device__ __forceinline__ void lru_item(const Params& p, int o, int item, const bf16_t* uc, const bf16_t* gates, bf16_t* hd, char* smem) {
  const int tidq = tid_(); const int gdq = gdim_(); const int bidq = bid_(); (void)gdq; (void)bidq;
  OPQ(uc); OPQ(gates); OPQ(hd);
  const int z = item >> 7, b = (item >> 3) & 15, cgp = item & 7;
  const int tid = tidq, c = tid & 63, seg = tid >> 6, ch = cgp * 64 + c;
  bf16_t* st = (bf16_t*)smem + seg * 6144;
  float* segP = (float*)(smem + 49152); float* segH = segP + 256;
  const float lam = p.lru_lambda[(o * 2 + z) * 512 + ch];
  const float kc = -8.f * log1pf(expf(-lam));
  float carry = 0.f;
  __syncthreads();
  for (int sc = 0; sc < 9; ++sc) {
    const int g0 = sc * 256 + seg * 64;
    int rbase; const int rstep = z ? -1 : 1;
    if (sc == 0) rbase = ML + b * 256 + (z ? 255 - g0 : g0);
    else { const int gl = g0 - 256; rbase = b * 2048 + (z ? 2047 - gl : gl); }
    float P = 1.f, H = 0.f, hin = 0.f;
#pragma unroll 1
    for (int pass = 0; pass < 2; ++pass) {
      if (pass == 1) H = hin;
#pragma unroll 1
      for (int half = 0; half < 2; ++half) {
        u32x4 lr[4], li[4], lu[4];
#pragma unroll
        for (int j = 0; j < 4; ++j) {
          const int q = c + 64 * j, stp = q >> 3, part = q & 7;
          const size_t row = (size_t)(rbase + rstep * (half * 32 + stp));
          const bf16_t* gp = gates + row * 2048 + z * 1024 + cgp * 64 + part * 8;
          lr[j] = *(const GL u32x4*)gp; li[j] = *(const GL u32x4*)(gp + 512);
          lu[j] = *(const GL u32x4*)(uc + row * 512 + cgp * 64 + part * 8);
        }
        __syncthreads();
#pragma unroll
        for (int j = 0; j < 4; ++j) {
          const int q = c + 64 * j;
          *(u32x4*)(st + q * 8) = lr[j]; *(u32x4*)(st + 2048 + q * 8) = li[j]; *(u32x4*)(st + 4096 + q * 8) = lu[j];
        }
        __syncthreads();
#pragma unroll 8
        for (int i = 0; i < 32; ++i) {
          const float rg = bf2f(st[i * 64 + c]), ig = bf2f(st[2048 + i * 64 + c]), u = bf2f(st[4096 + i * 64 + c]);
          const float la = kc * rg, a = __expf(la);
          const float t2 = 2.f * la;
          const float om = (t2 > -0.02f) ? -t2 * (1.f + t2 * (0.5f + t2 * 0.16666667f)) : 1.f - a * a;
          const float x = __builtin_amdgcn_sqrtf(fmaxf(om, 0.f)) * ig * u;
          H = a * H + x;
          if (pass == 0) P *= a;
          else hd[((size_t)z * MT + (size_t)(rbase + rstep * (half * 32 + i))) * 512 + ch] = f2bf(H);
        }
      }
      if (pass == 0) {
        segP[seg * 64 + c] = P; segH[seg * 64 + c] = H;
        __syncthreads();
        float h = carry;
#pragma unroll
        for (int s2 = 0; s2 < 4; ++s2) { if (s2 == seg) hin = h; h = segP[s2 * 64 + c] * h + segH[s2 * 64 + c]; }
        carry = h;
      }
    }
    __syncthreads();
  }
}
__device__ __forceinline__ void ph_lru_post(const bf16_t* hd, bf16_t* zo) {
  const int tidq = tid_(); const int gdq = gdim_(); const int bidq = bid_(); (void)gdq; (void)bidq;
  OPQ(hd); OPQ(zo);
  const int lane = tidq & 63, c = lane * 8;
  constexpr int R = 4;
  const int nw = gdq * 4;
  for (int row0 = bidq * 4 + (tidq >> 6); row0 < MT; row0 += nw * R) {
    u32x4 ua[R], ub[R], ug[R];
#pragma unroll
    for (int j = 0; j < R; ++j) {
      const int row = row0 + j * nw;
      if (row < MT) {
        ua[j] = *(const GL u32x4*)(hd + (size_t)row * 512 + c);
        ub[j] = *(const GL u32x4*)(hd + ((size_t)MT + row) * 512 + c);
        ug[j] = *(const GL u32x4*)(zo + (size_t)row * 2560 + 512 + c);
      }
    }
#pragma unroll
    for (int j = 0; j < R; ++j) {
      const int row = row0 + j * nw;
      if (row < MT) {
        float a[8], b2[8], g[8], o[8];
        unpack8(ua[j], a); unpack8(ub[j], b2); unpack8(ug[j], g);
#pragma unroll
        for (int i = 0; i < 8; ++i) {
          const float x = g[i];
          const float ge = 0.5f * x * (1.f + tanhf(0.7978845608028654f * (x + 0.044715f * x * x * x)));
          o[i] = (a[i] + b2[i]) * ge;
        }
        *(GL u32x4*)(zo + (size_t)row * 2560 + c) = pack8(o);
      }
    }
  }
}

__device__ __forceinline__ void attn_item(const Params& p, int o, int item, int local, bf16_t* zo, char* smem) {
  const int tidq = tid_(); const int gdq = gdim_(); const int bidq = bid_(); (void)gdq; (void)bidq;
  OPQ(zo);
  const int tid = tidq, lane = tid & 63, w = tid >> 6, fr = lane & 15, fq = lane >> 4;
  constexpr int VS = 524;
  bf16_t* Vt = (bf16_t*)smem;
  float* rpbs = (float*)(smem + 67072);
  int h, b, r = 0, r0 = 0, qrow, qcol = 0, band0 = 0;
  if (local) {
    h = item & 7; r = (item >> 3) & 31; b = item >> 8;
    r0 = min(max(r - 4, 0), 24);
    qcol = w * 16 + fr;
    band0 = min(max(w * 16 - 8, 0), 32);
    qrow = b * 2048 + r * 64 + qcol;
  } else {
    h = item & 7; b = (item >> 3) & 15;
    const int g4 = item >> 7;
    qrow = ML + b * 256 + g4 * 64 + w * 16 + fr;
  }
  const bf16_t* qp = zo + (size_t)qrow * 2560 + 1024 + h * 64;
  const bf16x8 qf0 = *(const GL bf16x8*)(qp + fq * 8), qf1 = *(const GL bf16x8*)(qp + 32 + fq * 8);
  float m1 = -1e30f, lsum = 0.f;
  f32x4 O[4];
#pragma unroll
  for (int i = 0; i < 4; ++i) O[i] = (f32x4){0.f, 0.f, 0.f, 0.f};
  __syncthreads();
  if (local) {
#pragma unroll 4
    for (int i = 0; i < 16; ++i) {
      const int idx = tid + 256 * i, tok = (idx & 7) + 8 * (idx >> 6), e8 = ((idx >> 3) & 7) * 8;
      const int row = b * 2048 + (r0 + (tok >> 6)) * 64 + (tok & 63);
      const u32x4 v = *(const GL u32x4*)(zo + (size_t)row * 2560 + 2048 + h * 64 + e8);
      const unsigned uu[4] = {v.x, v.y, v.z, v.w};
#pragma unroll
      for (int j = 0; j < 4; ++j) { Vt[(e8 + 2 * j) * VS + tok] = (bf16_t)(uu[j] & 0xffffu); Vt[(e8 + 2 * j + 1) * VS + tok] = (bf16_t)(uu[j] >> 16); }
    }
    for (int i = tid; i < 465; i += 256) rpbs[i] = p.na_rpb[(size_t)(o * 8 + h) * 465 + i];
    __syncthreads();
    f32x4 sc[16];
    const int win0 = min(max(qcol - 8, 0), 48);
    float mx = -1e30f;
#pragma unroll
    for (int ni = 0; ni < 16; ++ni) {
      const int kr = ni >> 1, j0 = (ni & 1) * 16;
      const bf16_t* kp = zo + (size_t)(b * 2048 + (r0 + kr) * 64 + band0 + j0 + fr) * 2560 + 1536 + h * 64;
      const bf16x8 k0 = *(const GL bf16x8*)(kp + fq * 8), k1 = *(const GL bf16x8*)(kp + 32 + fq * 8);
      f32x4 s = {0.f, 0.f, 0.f, 0.f};
      s = mfma16(k0, qf0, s); s = mfma16(k1, qf1, s);
      const int drow = r0 + kr - r + 7;
#pragma unroll
      for (int j = 0; j < 4; ++j) {
        const int kcol = band0 + j0 + fq * 4 + j;
        const int rel = kcol - win0;
        const int dcol = min(max(kcol - qcol + 15, 0), 30);
        const float val = (rel >= 0 && rel < 16) ? s[j] * 0.125f + rpbs[drow * 31 + dcol] : -1e30f;
        s[j] = val; mx = fmaxf(mx, val);
      }
      sc[ni] = s;
    }
    mx = fmaxf(mx, __shfl_xor(mx, 16)); mx = fmaxf(mx, __shfl_xor(mx, 32));
    m1 = mx;
#pragma unroll
    for (int a = 0; a < 8; ++a) {
      f32x4 p0, p1;
#pragma unroll
      for (int j = 0; j < 4; ++j) { p0[j] = __expf(sc[2 * a][j] - m1); p1[j] = __expf(sc[2 * a + 1][j] - m1); lsum += p0[j] + p1[j]; }
      const u32x2 a0 = pk4(p0), a1 = pk4(p1);
      const u32x4 pu = {a0.x, a0.y, a1.x, a1.y};
      const bf16x8 pf = *(const bf16x8*)&pu;
#pragma unroll
      for (int ne = 0; ne < 4; ++ne) {
        const bf16_t* vp = Vt + (ne * 16 + fr) * VS + a * 64 + band0 + fq * 4;
        const u32x2 lo = *(const u32x2*)vp, hi = *(const u32x2*)(vp + 16);
        const u32x4 vu = {lo.x, lo.y, hi.x, hi.y};
        O[ne] = mfma16(*(const bf16x8*)&vu, pf, O[ne]);
      }
    }
    __syncthreads();
  }
#pragma unroll 4
  for (int i = 0; i < 8; ++i) {
    const int idx = tid + 256 * i, tok = (idx & 7) + 8 * (idx >> 6), e8 = ((idx >> 3) & 7) * 8;
    const u32x4 v = *(const GL u32x4*)(zo + (size_t)(ML + b * 256 + tok) * 2560 + 2048 + h * 64 + e8);
    const unsigned uu[4] = {v.x, v.y, v.z, v.w};
#pragma unroll
    for (int j = 0; j < 4; ++j) { Vt[(e8 + 2 * j) * VS + tok] = (bf16_t)(uu[j] & 0xffffu); Vt[(e8 + 2 * j + 1) * VS + tok] = (bf16_t)(uu[j] >> 16); }
  }
  __syncthreads();
  {
    f32x4 sc[16];
    float mx = -1e30f;
#pragma unroll
    for (int ni = 0; ni < 16; ++ni) {
      const bf16_t* kp = zo + (size_t)(ML + b * 256 + ni * 16 + fr) * 2560 + 1536 + h * 64;
      const bf16x8 k0 = *(const GL bf16x8*)(kp + fq * 8), k1 = *(const GL bf16x8*)(kp + 32 + fq * 8);
      f32x4 s = {0.f, 0.f, 0.f, 0.f};
      s = mfma16(k0, qf0, s); s = mfma16(k1, qf1, s);
#pragma unroll
      for (int j = 0; j < 4; ++j) { s[j] *= 0.125f; mx = fmaxf(mx, s[j]); }
      sc[ni] = s;
    }
    mx = fmaxf(mx, __shfl_xor(mx, 16)); mx = fmaxf(mx, __shfl_xor(mx, 32));
    const float m2 = fmaxf(m1, mx);
    const float alpha = __expf(m1 - m2);
    lsum *= alpha;
#pragma unroll
    for (int ne = 0; ne < 4; ++ne) O[ne] *= alpha;
#pragma unroll
    for (int a = 0; a < 8; ++a) {
      f32x4 p0, p1;
#pragma unroll
      for (int j = 0; j < 4; ++j) { p0[j] = __expf(sc[2 * a][j] - m2); p1[j] = __expf(sc[2 * a + 1][j] - m2); lsum += p0[j] + p1[j]; }
      const u32x2 a0 = pk4(p0), a1 = pk4(p1);
      const u32x4 pu = {a0.x, a0.y, a1.x, a1.y};
      const bf16x8 pf = *(const bf16x8*)&pu;
#pragma unroll
      for (int ne = 0; ne < 4; ++ne) {
        const bf16_t* vp = Vt + (ne * 16 + fr) * VS + a * 32 + fq * 4;
        const u32x2 lo = *(const u32x2*)vp, hi = *(const u32x2*)(vp + 16);
        const u32x4 vu = {lo.x, lo.y, hi.x, hi.y};
        O[ne] = mfma16(*(const bf16x8*)&vu, pf, O[ne]);
      }
    }
  }
  lsum += __shfl_xor(lsum, 16); lsum += __shfl_xor(lsum, 32);
  const float inv = 1.f / lsum;
  bf16_t* op = zo + (size_t)qrow * 2560 + 1024 + h * 64 + fq * 4;
#pragma unroll
  for (int ne = 0; ne < 4; ++ne) *(GL u32x2*)(op + ne * 16) = pk4(O[ne] * inv);
  __syncthreads();
}


#define XB_TMO      128
#define XB_XCNT(j)  (256  + 64 * (j))
#define XB_XSUB(j)  (1280 + 64 * (j))
#define XB_XGEN(j)  (2304 + 64 * (j))
#define XB_TOP      3328
#define XB_TOPGEN   3392
#define XCD_BAR_WORDS 3456
#define XB_SPIN_CAP (1u << 18)
#define LAS __attribute__((address_space(3)))
__device__ __forceinline__ unsigned xb_ld(unsigned* p)              { return __hip_atomic_load(p, __ATOMIC_RELAXED, __HIP_MEMORY_SCOPE_AGENT); }
__device__ __forceinline__ unsigned xb_add(unsigned* p, unsigned v) { return __hip_atomic_fetch_add(p, v, __ATOMIC_RELAXED, __HIP_MEMORY_SCOPE_AGENT); }
__device__ __forceinline__ unsigned xb_xcc_id() { return (unsigned)__builtin_amdgcn_s_getreg((3 << 11) | 20) & 0xFu; }
#define XB_SPIN(cond, bar) do { unsigned _sp = 0; while (cond) { __builtin_amdgcn_s_sleep(1); \
    if ((++_sp & 255u) == 0u) { if (xb_ld(&(bar)[XB_TMO])) break; if (_sp > XB_SPIN_CAP) { atomicAdd(&(bar)[XB_TMO], 1u); break; } } } } while (0)
struct XcdBarrier { unsigned* bar; unsigned x; volatile LAS unsigned* st; };
__device__ __forceinline__ XcdBarrier xcd_barrier_post(unsigned* bar, volatile LAS unsigned* st) {
  XcdBarrier b; b.bar = bar; b.x = xb_xcc_id(); b.st = st;
  if (threadIdx.x == 0) (void)xb_add(&bar[XB_XCNT(b.x)], 1u);
  return b;
}
__device__ __forceinline__ void xcd_barrier_complete(unsigned* bar, unsigned x, unsigned& nloc, unsigned& nx) {
  const unsigned G = gridDim.x * gridDim.y * gridDim.z;
  unsigned sum, cnt, mine, sp = 0u;
  for (;;) {
    sum = 0u; cnt = 0u; mine = 0u;
#pragma unroll
    for (unsigned j = 0; j < 16; ++j) { const unsigned c = xb_ld(&bar[XB_XCNT(j)]); sum += c; cnt += (c > 0u) ? 1u : 0u; mine = (j == x) ? c : mine; }
    if (sum == G) break;
    __builtin_amdgcn_s_sleep(1);
    if ((++sp & 255u) == 0u) { if (xb_ld(&bar[XB_TMO])) break; if (sp > XB_SPIN_CAP) { atomicAdd(&bar[XB_TMO], 1u); break; } }
  }
  nloc = mine > 0u ? mine : 1u; nx = cnt > 0u ? cnt : 1u;
}
__device__ __forceinline__ void xcd_barrier(const XcdBarrier& b) {
  asm volatile("s_waitcnt vmcnt(0)" ::: "memory");
  __syncthreads();
  if (threadIdx.x == 0) {
    unsigned* bar = b.bar;
    __builtin_amdgcn_s_waitcnt(0);
    unsigned nloc = b.st[0], nx = b.st[1];
    if (nloc == 0u) { xcd_barrier_complete(bar, b.x, nloc, nx); b.st[0] = nloc; b.st[1] = nx; }
    const unsigned old = xb_add(&bar[XB_XSUB(b.x)], 1u);
    const unsigned gen = old / nloc;
    if (old + 1u == (gen + 1u) * nloc) {
      __builtin_amdgcn_fence(__ATOMIC_RELEASE, "agent");
      asm volatile("s_waitcnt vmcnt(0)" ::: "memory");
      const unsigned og = xb_add(&bar[XB_TOP], 1u);
      const unsigned tg = og / nx;
      if (og + 1u == (tg + 1u) * nx) xb_add(&bar[XB_TOPGEN], 1u);
      else XB_SPIN(xb_ld(&bar[XB_TOPGEN]) == tg, bar);
      __builtin_amdgcn_fence(__ATOMIC_ACQUIRE, "agent");
      xb_add(&bar[XB_XGEN(b.x)], 1u);
      asm volatile("s_waitcnt vmcnt(0)" ::: "memory");
    } else {
      XB_SPIN(xb_ld(&bar[XB_XGEN(b.x)]) == gen, bar);
      __builtin_amdgcn_fence(__ATOMIC_ACQUIRE, "agent");
      asm volatile("s_waitcnt vmcnt(0)" ::: "memory");
    }
  }
  __syncthreads();
}
#define WSN (opq_(*(char* const volatile*)&p.ws))
#define OUTN (opq_(*(float* const volatile*)&p.out))
#define XN_ (opq_(*(const float* const volatile*)&p.x))
#define CTXN_ (opq_(*(const float* const volatile*)&p.ctx))
#define B_mod ((float*)(WSN + OFF_MOD))
#define B_gates ((float*)(WSN + OFF_GATES))
#define B_WTIN ((const bf16_t*)(WSN + OFF_WTIN))
#define B_WTOUT ((const bf16_t*)(WSN + OFF_WTOUT))
#define B_WT1 ((const bf16_t*)(WSN + OFF_WT1))
#define B_WT2 ((const bf16_t*)(WSN + OFF_WT2))
#define B_xn ((bf16_t*)(WSN + OFF_ARENA))
#define B_zm ((bf16_t*)(WSN + OFF_ARENA + 2 * SU))
#define B_zw ((bf16_t*)(WSN + OFF_ARENA + 6 * SU))
#define B_mix ((bf16_t*)(WSN + OFF_ARENA + 9 * SU + 3 * (SU / 4)))
#define B_hm ((bf16_t*)(WSN + OFF_ARENA))
#define B_zr ((bf16_t*)(WSN + OFF_ARENA))
#define B_alin ((bf16_t*)(WSN + OFF_ARENA + 3 * SU))
#define B_ldp ((_Float16*)(WSN + OFF_ARENA + 3 * SU + 3 * (SU / 4)))
#define B_alr ((bf16_t*)(WSN + OFF_ARENA + 5 * SU + 3 * (SU / 4)))
#define B_gg ((bf16_t*)(WSN + OFF_ARENA + 7 * SU + 3 * (SU / 4)))
#define B_zo ((bf16_t*)(WSN + OFF_ARENA + 2 * SU))
#define B_uc ((bf16_t*)(WSN + OFF_ARENA + 7 * SU))
#define B_lg ((bf16_t*)(WSN + OFF_ARENA + 8 * SU))
#define B_hd ((bf16_t*)(WSN + OFF_ARENA))
#define B_uh ((bf16_t*)(WSN + OFF_ARENA + 2 * SU))
#define B_AR (WSN + OFF_ARENA)
#define B_ws (WSN)
__global__ void __launch_bounds__(256, 2) mega(Params pk) {
  cg::grid_group grid = cg::this_grid();
  if (blockDim.x == 7) grid.sync();
  __shared__ __attribute__((aligned(16))) char smem[73728];
  __shared__ Params sp_;
  __shared__ uint4 xb_words;
  if (threadIdx.x == 0) { sp_ = pk; xb_words = make_uint4(0u, 0u, 0u, 0u); }
  __syncthreads();
  const Params& p = sp_;
  XcdBarrier xb = xcd_barrier_post((unsigned*)(pk.ws + OFF_BAR), (volatile LAS unsigned*)&xb_words);
  const int NOJ = 1 << 30;

  if (blockIdx.x == 0 && threadIdx.x < 64) ((unsigned*)WSN)[threadIdx.x] = 0u;
  ph_prologue(p, smem);
  GSYNC();
  for (int l = 0; l < 4; ++l) {
    const bool last = (l == 3);
    const int Mrows = last ? ML : MT;
    ph_convert(p, l, smem);
    ph_norm(p, l, 0, MT, B_xn, l == 0);
    GSYNC();
    if (SKIP_EVEN && (l & 1) == 0) {
    } else if ((l & 1) == 0) {
      const int e = l >> 1;
      if (EVMASK & 1) gemm_phase(B_xn, 1024, NOJ, 0, B_WTIN, 1024, MT, 3984, 1024, EpiInEven{B_zm, B_zw, B_gates}, smem);
      GSYNC();
      if (EVMASK & 2) ph_rope(p, B_zm);
      GSYNC();
      if (!SKIP_MLSTM) for (int it = blockIdx.x; it < 256; it += gridDim.x) mlstm_item(p, e, it, B_zm, B_gates, B_hm, smem);
      GSYNC();
      if (EVMASK & 4) ph_mlstm_post(p, e, B_zm, B_hm, B_mix);
      GSYNC();
      if (EVMASK & 8) ph_rwkv_prep(p, e, B_zw, B_zr, B_alin);
      GSYNC();
      if ((EVMASK & 16)) for (int d = 0; d < 2; ++d) {
        gemm_phase(B_alin + d * 64, 384, NOJ, 0, (const bf16_t*)(B_ws + OFF_WUP) + d * 512 * 64, 64, MT, 512, 64,
                   EpiLd{B_ldp + (size_t)d * MT * 512, p.rw_w0 + (e * 2 + d) * 512}, smem);
        gemm_phase(B_alin + 128 + d * 64, 384, NOJ, 0, (const bf16_t*)(B_ws + OFF_AUP) + d * 512 * 64, 64, MT, 512, 64,
                   EpiAlr{B_alr + (size_t)d * MT * 512, p.rw_a0 + (e * 2 + d) * 512}, smem);
      }
      if ((EVMASK & 16)) gemm_phase(B_alin + 256, 384, NOJ, 0, (const bf16_t*)(B_ws + OFF_GUP), 128, MT, 512, 128, EpiStore{B_gg, 512}, smem);
      GSYNC();
      if (!SKIP_RWKV) for (int it = blockIdx.x; it < 256; it += gridDim.x) rwkv_item(p, e, it, B_zr, B_ldp, B_alr, smem);
      GSYNC();
      if (EVMASK & 32) ph_rwkv_post(p, e, B_zr, B_alr, B_gg, B_mix);
      GSYNC();
      if (EVMASK & 64) gemm_phase(B_mix, 1024, NOJ, 0, B_WTOUT, 1024, Mrows, 1024, 1024, EpiResid{OUTN, (float*)(B_ws + OFF_HCTX), B_mod + (size_t)l * 17 * 6144 + 2048, (l == 0 ? XN_ : (const float*)OUTN), (l == 0 ? CTXN_ : (const float*)(B_ws + OFF_HCTX))}, smem);
      GSYNC();
    } else if (!SKIP_ODD) {
      const int o = l >> 1;
      gemm_phase(B_xn, 1024, NOJ, 0, B_WTIN, 1024, MT, 2560, 1024, EpiStore{B_zo, 2560}, smem);
      GSYNC();
      ph_conv(p, o, B_zo, B_uc);
      GSYNC();
      gemm_phase_t<4>(B_uc, 512, NOJ, 0, (const bf16_t*)(B_ws + OFF_GWT), 64, MT, 2048, 64, EpiGates{B_lg, p.lru_gate_b + o * 2048}, smem, 256);
      GSYNC();
      {
        const int n_lru = 256, n_na = 4096, n_ca = last ? 0 : 512;
        __shared__ int s_it;
        unsigned* ctr = (unsigned*)WSN + 16 * o;
        for (;;) {
          __syncthreads();
          if (threadIdx.x == 0) s_it = (int)atomicAdd(ctr, 1u);
          __syncthreads();
          const int it = s_it;
          if (it >= n_lru + n_na + n_ca) break;
          if (it < n_lru) lru_item(p, o, it, B_uc, B_lg, B_hd, smem);
          else if (it < n_lru + n_na) attn_item(p, o, it - n_lru, 1, B_zo, smem);
          else attn_item(p, o, it - n_lru - n_na, 0, B_zo, smem);
        }
      }
      GSYNC();
      ph_lru_post(B_hd, B_zo);
      GSYNC();
      gemm_phase(B_zo, 2560, 512, 512, B_WTOUT, 1024, Mrows, 1024, 1024, EpiResid{OUTN, (float*)(B_ws + OFF_HCTX), B_mod + (size_t)l * 17 * 6144 + 2048, (l == 0 ? XN_ : (const float*)OUTN), (l == 0 ? CTXN_ : (const float*)(B_ws + OFF_HCTX))}, smem);
      GSYNC();
    }
    ph_norm(p, l, 1, Mrows, B_xn);
    GSYNC();
    gemm_phase(B_xn, 1024, NOJ, 0, B_WT1, 1024, Mrows, 4096, 1024, EpiMlp1{B_uh}, smem);
    GSYNC();
    gemm_phase(B_uh, 4096, NOJ, 0, B_WT2, 4096, Mrows, 1024, 4096, EpiResid{OUTN, (float*)(B_ws + OFF_HCTX), B_mod + (size_t)l * 17 * 6144 + 5120, (const float*)OUTN, (const float*)(B_ws + OFF_HCTX)}, smem);
    GSYNC();
  }
  ph_final_norm(p);
}

extern "C" void kernel_launch(void* const* d_in, const int* in_sizes, int n_in, void* d_out, int out_size,
                              void* d_ws, size_t ws_size, hipStream_t stream) {
  static int grid_blocks = 0;
  if (!grid_blocks) {
    int dev = 0, cus = 0, per_cu = 0;
    (void)hipGetDevice(&dev);
    (void)hipDeviceGetAttribute(&cus, hipDeviceAttributeMultiprocessorCount, dev);
    (void)hipOccupancyMaxActiveBlocksPerMultiprocessor(&per_cu, mega, 256, 0);
    if (per_cu > 2) per_cu = 2;
    if (per_cu < 1) per_cu = 1;
    grid_blocks = cus * per_cu;
  }
  Params p{};
  const float** pp = (const float**)&p;
  for (int i = 0; i < 31; ++i) pp[i] = (const float*)d_in[i];
  p.out = (float*)d_out;
  p.ws = (char*)d_ws;
  (void)hipMemsetAsync((char*)d_ws + OFF_BAR, 0, 16384, stream);
  void* args[] = {&p};
  hipError_t e = hipLaunchCooperativeKernel((void*)mega, dim3(grid_blocks), dim3(256), args, 0, stream);
  if (e != hipSuccess) fprintf(stderr, "cooperative launch failed: %s (grid %d)\n", hipGetErrorString(e), grid_blocks);
}
```

```cpp
#include <hip/hip_runtime.h>
#include <hip/hip_cooperative_groups.h>
#include <cstdio>
#include <cstdint>
namespace cg = cooperative_groups;
#define GSYNC() xcd_barrier(xb)
#define SKIP_EVEN 0
#define EVMASK 127
#define SKIP_ODD 0
#define SKIP_RWKV 0
#define SKIP_MLSTM 0

typedef unsigned short bf16_t;
typedef short bf16x8 __attribute__((ext_vector_type(8)));
typedef float f32x4 __attribute__((ext_vector_type(4)));
typedef float f32x2 __attribute__((ext_vector_type(2)));
typedef unsigned u32x4 __attribute__((ext_vector_type(4)));
typedef unsigned u32x2 __attribute__((ext_vector_type(2)));
#define GL __attribute__((address_space(1)))

constexpr int ML = 32768, MC = 4096, MT = ML + MC;
constexpr size_t SU = 37748736ull;
constexpr size_t OFF_HCTX = 4096;
constexpr size_t OFF_MOD = OFF_HCTX + 16777216ull;
constexpr size_t OFF_ROPEC = OFF_MOD + 1671168ull;
constexpr size_t OFF_ROPES = OFF_ROPEC + 524288ull;
constexpr size_t OFF_GATES = OFF_ROPES + 524288ull;
constexpr size_t OFF_WTIN = OFF_GATES + 2359296ull;
constexpr size_t OFF_WTOUT = OFF_WTIN + 8388608ull;
constexpr size_t OFF_WT1 = OFF_WTOUT + 2097152ull;
constexpr size_t OFF_WT2 = OFF_WT1 + 8388608ull;
constexpr size_t OFF_WUP = OFF_WT2 + 8388608ull;
constexpr size_t OFF_AUP = OFF_WUP + 131072ull;
constexpr size_t OFF_GUP = OFF_AUP + 131072ull;
constexpr size_t OFF_GWT = OFF_GUP + 131072ull;
constexpr size_t OFF_BAR = OFF_GWT + 262144ull;
constexpr size_t OFF_ARENA = 50331648ull;
static_assert(OFF_BAR + 16384ull <= OFF_ARENA, "persistent region overflow");

struct Params {
  const float *x, *c, *ctx, *c_ctx, *ada_w, *ada_b, *mix_out_w, *mlp_w1, *mlp_w2, *ev_in_w, *ml_gate_b, *ml_norm_w,
      *rw_mu, *rw_w0, *rw_w_up, *rw_a0, *rw_a_up, *rw_g_up, *rw_k_k, *rw_k_a, *rw_r_k, *rw_ln_w, *rw_ln_b, *od_in_w,
      *lru_conv_w, *lru_conv_b, *lru_gate_w, *lru_gate_b, *lru_lambda, *na_rpb, *final_norm_w;
  float* out;
  char* ws;
};

__device__ __forceinline__ float bf2f(unsigned h) { return __uint_as_float(h << 16); }
__device__ __forceinline__ float bflo(unsigned u) { return __uint_as_float(u << 16); }
__device__ __forceinline__ float bfhi(unsigned u) { return __uint_as_float(u & 0xffff0000u); }
typedef __bf16 bf16x2_t __attribute__((ext_vector_type(2)));
__device__ __forceinline__ unsigned pk2(float lo, float hi) {
  f32x2 v = {lo, hi};
  bf16x2_t b = __builtin_convertvector(v, bf16x2_t);
  return __builtin_bit_cast(unsigned, b);
}
__device__ __forceinline__ bf16_t f2bf(float f) { return (bf16_t)(pk2(f, 0.f) & 0xffffu); }
__device__ __forceinline__ u32x2 pk4(f32x4 v) { u32x2 r; r.x = pk2(v[0], v[1]); r.y = pk2(v[2], v[3]); return r; }
__device__ __forceinline__ void unpack8(u32x4 u, float* f) {
  f[0] = bflo(u.x); f[1] = bfhi(u.x); f[2] = bflo(u.y); f[3] = bfhi(u.y);
  f[4] = bflo(u.z); f[5] = bfhi(u.z); f[6] = bflo(u.w); f[7] = bfhi(u.w);
}
__device__ __forceinline__ u32x4 pack8(const float* f) {
  u32x4 r; r.x = pk2(f[0], f[1]); r.y = pk2(f[2], f[3]); r.z = pk2(f[4], f[5]); r.w = pk2(f[6], f[7]); return r;
}
__device__ __forceinline__ float sigm(float x) { return 1.f / (1.f + __expf(-x)); }
__device__ __forceinline__ f32x4 mfma16(bf16x8 a, bf16x8 b, f32x4 c) { return __builtin_amdgcn_mfma_f32_16x16x32_bf16(a, b, c, 0, 0, 0); }
template <class T> __device__ __forceinline__ T* opq_(T* p) {
  unsigned lo = __builtin_amdgcn_readfirstlane((unsigned)(uintptr_t)p);
  unsigned hi = __builtin_amdgcn_readfirstlane((unsigned)((uintptr_t)p >> 32));
  asm volatile("" : "+s"(lo), "+s"(hi));
  return (T*)(((uintptr_t)hi << 32) | (uintptr_t)lo);
}
#define OPQ(x) x = opq_(x)
__device__ __forceinline__ int tid_() { int t = threadIdx.x; asm volatile("" : "+v"(t)); return t; }
__device__ __forceinline__ int gdim_() { int t = gridDim.x; asm volatile("" : "+s"(t)); return t; }
__device__ __forceinline__ int bid_() { int t = blockIdx.x; asm volatile("" : "+s"(t)); return t; }
__device__ __forceinline__ float* hrow2(float* out, float* hctx, int row) {
  return row < ML ? out + (size_t)row * 1024 : hctx + (size_t)(row - ML) * 1024;
}
__device__ __forceinline__ int mrow_of(int row) { return row < ML ? (row >> 11) : 16; }
template <int CTRL> __device__ __forceinline__ float dppf(float x) {
  return __int_as_float(__builtin_amdgcn_update_dpp(0, __float_as_int(x), CTRL, 0xF, 0xF, true));
}
__device__ __forceinline__ float red8(float x) {
  x += dppf<0xB1>(x); x += dppf<0x4E>(x); x += dppf<0x141>(x); return x;
}
__device__ __forceinline__ float wave_sum(float v) {
#pragma unroll
  for (int o = 32; o > 0; o >>= 1) v += __shfl_xor(v, o);
  return v;
}

__device__ __forceinline__ void convT_tile(const float* src, int N, int k0, int n0, bf16_t* dst, int ldd, float* tile) {
  const int tidq = tid_(); const int gdq = gdim_(); const int bidq = bid_(); (void)gdq; (void)bidq;
  OPQ(src); OPQ(dst);
  const int t = tidq, c4 = (t & 15) * 4, r = t >> 4;
#pragma unroll
  for (int i = 0; i < 4; ++i) {
    const int k = r + 16 * i;
    f32x4 v = {0.f, 0.f, 0.f, 0.f};
    if (n0 + c4 < N) v = *(const GL f32x4*)(src + (size_t)(k0 + k) * N + n0 + c4);
    tile[k * 65 + c4 + 0] = v[0]; tile[k * 65 + c4 + 1] = v[1]; tile[k * 65 + c4 + 2] = v[2]; tile[k * 65 + c4 + 3] = v[3];
  }
  __syncthreads();
  const int n = t >> 2, kq = (t & 3) * 16;
  float f[16];
#pragma unroll
  for (int j = 0; j < 16; ++j) f[j] = tile[(kq + j) * 65 + n];
  bf16_t* d = dst + (size_t)(n0 + n) * ldd + k0 + kq;
  *(GL u32x4*)d = pack8(f);
  *(GL u32x4*)(d + 8) = pack8(f + 8);
  __syncthreads();
}
__device__ __forceinline__ void conv_matrix(const float* src, int K, int N, int Npad, bf16_t* dst, int ldd, float* tile) {
  const int tidq = tid_(); const int gdq = gdim_(); const int bidq = bid_(); (void)gdq; (void)bidq;
  const int ntk = K / 64, ntn = Npad / 64;
  for (int t = bidq; t < ntk * ntn; t += gdq) convT_tile(src, N, (t % ntk) * 64, (t / ntk) * 64, dst, ldd, tile);
}
__device__ __forceinline__ void ph_convert(const Params& p, int l, char* smem) {
  const int tidq = tid_(); const int gdq = gdim_(); const int bidq = bid_(); (void)gdq; (void)bidq;
  float* tile = (float*)smem;
  char* ws = p.ws;
  if ((l & 1) == 0) {
    const int e = l >> 1;
    conv_matrix(p.ev_in_w + (size_t)e * 1024 * 3984, 1024, 3984, 4096, (bf16_t*)(ws + OFF_WTIN), 1024, tile);
    for (int d = 0; d < 2; ++d) {
      conv_matrix(p.rw_w_up + (size_t)(e * 2 + d) * 64 * 512, 64, 512, 512, (bf16_t*)(ws + OFF_WUP) + d * 512 * 64, 64, tile);
      conv_matrix(p.rw_a_up + (size_t)(e * 2 + d) * 64 * 512, 64, 512, 512, (bf16_t*)(ws + OFF_AUP) + d * 512 * 64, 64, tile);
    }
    conv_matrix(p.rw_g_up + (size_t)e * 128 * 512, 128, 512, 512, (bf16_t*)(ws + OFF_GUP), 128, tile);
  } else {
    const int o = l >> 1;
    conv_matrix(p.od_in_w + (size_t)o * 1024 * 2560, 1024, 2560, 2560, (bf16_t*)(ws + OFF_WTIN), 1024, tile);
    for (int t = bidq; t < 32; t += gdq) {
      const int zg = t >> 3, n = t & 7;
      convT_tile(p.lru_gate_w + (size_t)(((o * 4 + zg) * 8 + n)) * 4096, 64, 0, 0, (bf16_t*)(ws + OFF_GWT) + (size_t)n * 256 * 64 + zg * 64 * 64, 64, tile);
    }
  }
  conv_matrix(p.mix_out_w + (size_t)l * 1024 * 1024, 1024, 1024, 1024, (bf16_t*)(ws + OFF_WTOUT), 1024, tile);
  conv_matrix(p.mlp_w1 + (size_t)l * 1024 * 4096, 1024, 4096, 4096, (bf16_t*)(ws + OFF_WT1), 1024, tile);
  conv_matrix(p.mlp_w2 + (size_t)l * 4096 * 1024, 4096, 1024, 1024, (bf16_t*)(ws + OFF_WT2), 4096, tile);
}

__device__ __forceinline__ void ph_prologue(const Params& p, char* smem) {
  const int tidq = tid_(); const int gdq = gdim_(); const int bidq = bid_(); (void)gdq; (void)bidq;
  const int gtid = bidq * 256 + tidq, gsz = gdq * 256;
  {
    float* rc = (float*)(p.ws + OFF_ROPEC); float* rs = (float*)(p.ws + OFF_ROPES);
    for (int i = gtid; i < 2048 * 64; i += gsz) {
      const int t = i >> 6, f = i & 63;
      const float pos = (f < 32) ? (float)(t >> 6) : (float)(t & 63);
      const float inv = powf(10000.0f, -(float)(f & 31) / 32.0f);
      const float ang = pos * inv;
      rc[i] = cosf(ang); rs[i] = sinf(ang);
    }
  }
  float* s = (float*)smem;
  float* mod = (float*)(p.ws + OFF_MOD);
  for (int item = bidq; item < 384; item += gdq) {
    const int l = item / 96, n0 = (item % 96) * 64;
    for (int idx = tidq; idx < 17 * 1024; idx += 256) {
      const int r = idx >> 10, k = idx & 1023;
      const float cv = r < 16 ? p.c[r * 1024 + k] : p.c_ctx[k];
      s[idx] = cv / (1.f + expf(-cv));
    }
    __syncthreads();
    const int kq = tidq >> 6, nn = tidq & 63;
    float acc[17];
#pragma unroll
    for (int r = 0; r < 17; ++r) acc[r] = 0.f;
    const float* wp = p.ada_w + ((size_t)l * 1024 + kq * 256) * 6144 + n0 + nn;
    for (int k = 0; k < 256; k += 4) {
      const float w0 = wp[(size_t)(k + 0) * 6144], w1 = wp[(size_t)(k + 1) * 6144], w2 = wp[(size_t)(k + 2) * 6144], w3 = wp[(size_t)(k + 3) * 6144];
#pragma unroll
      for (int r = 0; r < 17; ++r) {
        const f32x4 sv = *(const f32x4*)(s + r * 1024 + kq * 256 + k);
        acc[r] += sv[0] * w0 + sv[1] * w1 + sv[2] * w2 + sv[3] * w3;
      }
    }
    __syncthreads();
#pragma unroll
    for (int r = 0; r < 17; ++r) s[(kq * 17 + r) * 64 + nn] = acc[r];
    __syncthreads();
    for (int idx = tidq; idx < 17 * 64; idx += 256) {
      const int r = idx >> 6, n = idx & 63;
      float v = p.ada_b[l * 6144 + n0 + n];
#pragma unroll
      for (int q = 0; q < 4; ++q) v += s[(q * 17 + r) * 64 + n];
      mod[((size_t)l * 17 + r) * 6144 + n0 + n] = v;
    }
    __syncthreads();
  }
}

__device__ __forceinline__ void ph_norm(const Params& p, int l, int which, int Mrows, bf16_t* xn, bool from_input = false) {
  const int tidq = tid_(); const int gdq = gdim_(); const int bidq = bid_(); (void)gdq; (void)bidq;
  const int lane = tidq & 63;
  float* out_ = from_input ? (float*)p.x : p.out; char* ws_ = p.ws; OPQ(out_); OPQ(ws_); OPQ(xn);
  float* hctx_ = from_input ? (float*)p.ctx : (float*)(ws_ + OFF_HCTX); OPQ(hctx_);
  const float* mod = (const float*)(ws_ + OFF_MOD) + (size_t)l * 17 * 6144 + which * 3072;
  constexpr int R = 4;
  const int nw = gdq * 4;
  for (int row0 = bidq * 4 + (tidq >> 6); row0 < Mrows; row0 += nw * R) {
    f32x4 v[R][4];
#pragma unroll
    for (int j = 0; j < R; ++j) {
      const int row = row0 + j * nw;
      if (row < Mrows) {
        const float* h = hrow2(out_, hctx_, row);
#pragma unroll
        for (int i = 0; i < 4; ++i) v[j][i] = *(const GL f32x4*)(h + i * 256 + lane * 4);
      }
    }
#pragma unroll
    for (int j = 0; j < R; ++j) {
      const int row = row0 + j * nw;
      if (row < Mrows) {
        float ss = 0.f;
#pragma unroll
        for (int i = 0; i < 4; ++i) ss += v[j][i][0] * v[j][i][0] + v[j][i][1] * v[j][i][1] + v[j][i][2] * v[j][i][2] + v[j][i][3] * v[j][i][3];
        ss = wave_sum(ss);
        const float rstd = rsqrtf(ss * (1.f / 1024.f) + 1e-6f);
        const float* m = mod + (size_t)mrow_of(row) * 6144;
#pragma unroll
        for (int i = 0; i < 4; ++i) {
          const int col = i * 256 + lane * 4;
          const f32x4 sh = *(const GL f32x4*)(m + col), sc = *(const GL f32x4*)(m + 1024 + col);
          f32x4 o = v[j][i] * rstd * (sc + 1.f) + sh;
          *(GL u32x2*)(xn + (size_t)row * 1024 + col) = pk4(o);
        }
      }
    }
  }
}
__device__ __forceinline__ void ph_final_norm(const Params& p) {
  const int tidq = tid_(); const int gdq = gdim_(); const int bidq = bid_(); (void)gdq; (void)bidq;
  const int lane = tidq & 63;
  float* out_ = p.out; OPQ(out_);
  constexpr int R = 4;
  const int nw = gdq * 4;
  for (int row0 = bidq * 4 + (tidq >> 6); row0 < ML; row0 += nw * R) {
    f32x4 v[R][4];
#pragma unroll
    for (int j = 0; j < R; ++j) {
      const int row = row0 + j * nw;
      if (row < ML) {
#pragma unroll
        for (int i = 0; i < 4; ++i) v[j][i] = *(const GL f32x4*)(out_ + (size_t)row * 1024 + i * 256 + lane * 4);
      }
    }
#pragma unroll
    for (int j = 0; j < R; ++j) {
      const int row = row0 + j * nw;
      if (row < ML) {
        float ss = 0.f;
#pragma unroll
        for (int i = 0; i < 4; ++i) ss += v[j][i][0] * v[j][i][0] + v[j][i][1] * v[j][i][1] + v[j][i][2] * v[j][i][2] + v[j][i][3] * v[j][i][3];
        ss = wave_sum(ss);
        const float rstd = rsqrtf(ss * (1.f / 1024.f) + 1e-6f);
#pragma unroll
        for (int i = 0; i < 4; ++i) {
          const int col = i * 256 + lane * 4;
          const f32x4 w = *(const GL f32x4*)(p.final_norm_w + col);
          *(GL f32x4*)(out_ + (size_t)row * 1024 + col) = v[j][i] * rstd * w;
        }
      }
    }
  }
}

template <int MI, class Epi>
__device__ __forceinline__ void gemm_phase_t(const bf16_t* A, int lda, int jump_at, int jump, const bf16_t* Bt, int ldb,
                           int Mrows, int N, int K, Epi epi, char* smem, int a_grp = 0) {
  const int tidq = tid_(); const int gdq = gdim_(); const int bidq = bid_();
  OPQ(A); OPQ(Bt); epi.launder();
  const int tid = tidq, lane = tid & 63, w = tid >> 6, wr = w >> 1, wc = w & 1, fr = lane & 15, fq = lane >> 4;
  constexpr int BM = MI * 32;
  const int ntm = Mrows / BM, ntn = (N + 127) / 128, nk = K / 64;
  char* As = smem;
  char* Bs = As + BM * 128;
  const int lrow = tid >> 3, lc = (tid & 7) * 8;
  const int lsw = ((tid & 7) ^ ((lrow >> 1) & 7)) << 4;
  const int rsw = (fr >> 1) & 7;
  const int xcd = bidq & 7, slot = bidq >> 3, nslot = gdq >> 3;
  const bool xmap = ((ntm & 7) == 0) && ((gdq & 7) == 0);
  const int ntml = ntm >> 3;
  const int tper = xmap ? ntml * ntn : ntm * ntn;
  const int tj0 = xmap ? slot : bidq, tjs = xmap ? nslot : gdq;
  const int BW = (ntn >= 16) ? 4 : 8;
#define TILE_OF(TJ, M0, N0) { int tm_, tn_; \
    if (xmap) { const int band_ = (TJ) / (BW * ntn), rem_ = (TJ) - band_ * BW * ntn; const int rib_ = min(BW, ntml - band_ * BW); \
      tn_ = rem_ / rib_; tm_ = (band_ * BW + (rem_ - tn_ * rib_)) * 8 + xcd; } \
    else { tm_ = (TJ) / ntn; tn_ = (TJ) % ntn; } \
    M0 = tm_ * BM; N0 = tn_ * 128; }
  u32x4 ra[MI], rb[4];
#define GLOAD(AP, BP, KT) { const int k0_ = (KT) * 64 + lc, ka_ = k0_ + (k0_ >= jump_at ? jump : 0); \
      _Pragma("unroll") for (int i = 0; i < MI; ++i) ra[i] = *(const GL u32x4*)((AP) + (size_t)(32 * i) * lda + ka_); \
      _Pragma("unroll") for (int i = 0; i < 4; ++i) rb[i] = *(const GL u32x4*)((BP) + (size_t)(32 * i) * ldb + k0_); }
  if (tj0 < tper) {
    int m0, n0; TILE_OF(tj0, m0, n0);
    GLOAD(A + (size_t)(m0 + lrow) * lda + (a_grp ? (n0 / a_grp) * K : 0), Bt + (size_t)(n0 + lrow) * ldb, 0);
  }
  for (int tj = tj0; tj < tper; tj += tjs) {
    int m0, n0; TILE_OF(tj, m0, n0);
    int m1 = m0, n1 = n0;
    const bool has_next = (tj + tjs) < tper;
    if (has_next) TILE_OF(tj + tjs, m1, n1);
    f32x4 acc[MI][4];
#pragma unroll
    for (int i = 0; i < MI; ++i)
#pragma unroll
      for (int j = 0; j < 4; ++j) acc[i][j] = (f32x4){0.f, 0.f, 0.f, 0.f};
    const bf16_t* Ap = A + (size_t)(m0 + lrow) * lda + (a_grp ? (n0 / a_grp) * K : 0);
    const bf16_t* Bp = Bt + (size_t)(n0 + lrow) * ldb;
    const bf16_t* Ap1 = A + (size_t)(m1 + lrow) * lda + (a_grp ? (n1 / a_grp) * K : 0);
    const bf16_t* Bp1 = Bt + (size_t)(n1 + lrow) * ldb;
    if constexpr (MI > 6) { if (tj != tj0) GLOAD(Ap, Bp, 0); }
    for (int kt = 0; kt < nk; ++kt) {
      __syncthreads();
#pragma unroll
      for (int i = 0; i < MI; ++i) *(u32x4*)(As + (lrow + 32 * i) * 128 + lsw) = ra[i];
#pragma unroll
      for (int i = 0; i < 4; ++i) *(u32x4*)(Bs + (lrow + 32 * i) * 128 + lsw) = rb[i];
      __syncthreads();
      {
        if constexpr (MI <= 6) {
          const bool lastk = (kt + 1 == nk);
          const bf16_t* ap_ = lastk ? Ap1 : Ap;
          const bf16_t* bp_ = lastk ? Bp1 : Bp;
          const int kn_ = lastk ? 0 : kt + 1;
          GLOAD(ap_, bp_, kn_);
        } else {
          GLOAD(Ap, Bp, min(kt + 1, nk - 1));
        }
      }
#pragma unroll
      for (int ks = 0; ks < 2; ++ks) {
        bf16x8 bfr[4];
#pragma unroll
        for (int ni = 0; ni < 4; ++ni) bfr[ni] = *(const bf16x8*)(Bs + (wc * 64 + ni * 16 + fr) * 128 + (((ks * 4 + fq) ^ rsw) << 4));
#pragma unroll
        for (int mi = 0; mi < MI; ++mi) {
          const bf16x8 af = *(const bf16x8*)(As + (wr * (BM / 2) + mi * 16 + fr) * 128 + (((ks * 4 + fq) ^ rsw) << 4));
#pragma unroll
          for (int ni = 0; ni < 4; ++ni) acc[mi][ni] = mfma16(bfr[ni], af, acc[mi][ni]);
        }
      }
    }
#pragma unroll
    for (int mi = 0; mi < MI; ++mi)
#pragma unroll
      for (int ni = 0; ni < 4; ++ni) {
        const int row = m0 + wr * (BM / 2) + mi * 16 + fr, col = n0 + wc * 64 + ni * 16 + fq * 4;
        if (col < N) epi(row, col, acc[mi][ni]);
      }
  }
#undef GLOAD
#undef TILE_OF
}

template <class Epi>
__device__ __forceinline__ void gemm_phase(const bf16_t* A, int lda, int jump_at, int jump, const bf16_t* Bt, int ldb,
                           int Mrows, int N, int K, Epi epi, char* smem) {
  if (N <= 512) gemm_phase_t<4>(A, lda, jump_at, jump, Bt, ldb, Mrows, N, K, epi, smem);
  else if (N == 1024 && Mrows == MT) gemm_phase_t<6>(A, lda, jump_at, jump, Bt, ldb, Mrows, N, K, epi, smem);
  else gemm_phase_t<8>(A, lda, jump_at, jump, Bt, ldb, Mrows, N, K, epi, smem);
}

struct EpiInEven {
  bf16_t* zm; bf16_t* zw; float* gates;
  __device__ __forceinline__ void launder() { OPQ(zm); OPQ(zw); OPQ(gates); }
  __device__ __forceinline__ void operator()(int row, int col, f32x4 v) const {
    if (col < 2048) *(GL u32x2*)(zm + (size_t)row * 2048 + col) = pk4(v);
    else if (col < 2064) *(GL f32x4*)(gates + (size_t)row * 16 + (col - 2048)) = v;
    else *(GL u32x2*)(zw + (size_t)row * 1920 + (col - 2064)) = pk4(v);
  }
};
struct EpiStore {
  bf16_t* o; int ld;
  __device__ __forceinline__ void launder() { OPQ(o); }
  __device__ __forceinline__ void operator()(int row, int col, f32x4 v) const { *(GL u32x2*)(o + (size_t)row * ld + col) = pk4(v); }
};
struct EpiResid {
  float* out; float* hctx; const float* gate; const float* srcl; const float* srcc;
  __device__ __forceinline__ void launder() { OPQ(out); OPQ(hctx); OPQ(gate); OPQ(srcl); OPQ(srcc); }
  __device__ __forceinline__ void operator()(int row, int col, f32x4 v) const {
    float* h = hrow2(out, hctx, row) + col;
    const float* hs = (row < ML ? srcl + (size_t)row * 1024 : srcc + (size_t)(row - ML) * 1024) + col;
    const f32x4 g = *(const GL f32x4*)(gate + (size_t)mrow_of(row) * 6144 + col);
    f32x4 hv = *(const GL f32x4*)hs;
    hv += g * v;
    *(GL f32x4*)h = hv;
  }
};
struct EpiMlp1 {
  bf16_t* u;
  __device__ __forceinline__ void launder() { OPQ(u); }
  __device__ __forceinline__ void operator()(int row, int col, f32x4 v) const {
    f32x4 r;
#pragma unroll
    for (int i = 0; i < 4; ++i) { const float t = fmaxf(v[i], 0.f); r[i] = t * t; }
    *(GL u32x2*)(u + (size_t)row * 4096 + col) = pk4(r);
  }
};
struct EpiLd {
  _Float16* ld; const float* w0;
  __device__ __forceinline__ void launder() { OPQ(ld); OPQ(w0); }
  __device__ __forceinline__ void operator()(int row, int col, f32x4 v) const {
    const f32x4 b = *(const GL f32x4*)(w0 + col);
    _Float16 o[4];
#pragma unroll
    for (int i = 0; i < 4; ++i) o[i] = (_Float16)(-0.60653065971f * sigm(v[i] + b[i]));
    *(GL u32x2*)(ld + (size_t)row * 512 + col) = *(const u32x2*)o;
  }
};
struct EpiAlr {
  bf16_t* alr; const float* a0;
  __device__ __forceinline__ void launder() { OPQ(alr); OPQ(a0); }
  __device__ __forceinline__ void operator()(int row, int col, f32x4 v) const {
    const f32x4 b = *(const GL f32x4*)(a0 + col);
    f32x4 r;
#pragma unroll
    for (int i = 0; i < 4; ++i) r[i] = sigm(v[i] + b[i]);
    *(GL u32x2*)(alr + (size_t)row * 512 + col) = pk4(r);
  }
};
struct EpiGates {
  bf16_t* g; const float* gb;
  __device__ __forceinline__ void launder() { OPQ(g); OPQ(gb); }
  __device__ __forceinline__ void operator()(int row, int colv, f32x4 v) const {
    const int n = colv >> 8, cl = colv & 255;
    const int zg = cl >> 6, d = cl & 63, c = zg * 512 + n * 64 + d;
    const f32x4 b = *(const GL f32x4*)(gb + c);
    f32x4 r;
#pragma unroll
    for (int i = 0; i < 4; ++i) r[i] = sigm(v[i] + b[i]);
    *(GL u32x2*)(g + (size_t)row * 2048 + c) = pk4(r);
  }
};

__device__ __forceinline__ void ph_rope(const Params& p, bf16_t* zm) {
  const int tidq = tid_(); const int gdq = gdim_(); const int bidq = bid_(); (void)gdq; (void)bidq;
  OPQ(zm);
  const int lane = tidq & 63;
  const int part = lane >> 5, head = (lane >> 3) & 3, d = (lane & 7) * 8;
  char* ws_ = p.ws; OPQ(ws_);
  const float* rc = (const float*)(ws_ + OFF_ROPEC); const float* rs = (const float*)(ws_ + OFF_ROPES);
  const float sc = part ? 0.08838834764831845f : 1.f;
  constexpr int R = 4;
  const int nw = gdq * 4;
  for (int row0 = bidq * 4 + (tidq >> 6); row0 < MT; row0 += nw * R) {
    u32x4 a[R], b[R];
    f32x4 c0[R], c1[R], s0[R], s1[R];
#pragma unroll
    for (int j = 0; j < R; ++j) {
      const int row = row0 + j * nw;
      if (row < MT) {
        bf16_t* base = zm + (size_t)row * 2048 + part * 512 + head * 128;
        a[j] = *(const GL u32x4*)(base + d); b[j] = *(const GL u32x4*)(base + 64 + d);
        if (row < ML) {
          const int t = row & 2047;
          c0[j] = *(const GL f32x4*)(rc + t * 64 + d); c1[j] = *(const GL f32x4*)(rc + t * 64 + d + 4);
          s0[j] = *(const GL f32x4*)(rs + t * 64 + d); s1[j] = *(const GL f32x4*)(rs + t * 64 + d + 4);
        }
      }
    }
#pragma unroll
    for (int j = 0; j < R; ++j) {
      const int row = row0 + j * nw;
      if (row < MT) {
        bf16_t* base = zm + (size_t)row * 2048 + part * 512 + head * 128;
        float x1[8], x2[8], o1[8], o2[8];
        unpack8(a[j], x1); unpack8(b[j], x2);
        if (row < ML) {
#pragma unroll
          for (int i = 0; i < 8; ++i) {
            const float c = i < 4 ? c0[j][i & 3] : c1[j][i & 3], s = i < 4 ? s0[j][i & 3] : s1[j][i & 3];
            o1[i] = (x1[i] * c - x2[i] * s) * sc; o2[i] = (x1[i] * s + x2[i] * c) * sc;
          }
        } else {
#pragma unroll
          for (int i = 0; i < 8; ++i) { o1[i] = x1[i] * sc; o2[i] = x2[i] * sc; }
        }
        if (row < ML || part) { *(GL u32x4*)(base + d) = pack8(o1); *(GL u32x4*)(base + 64 + d) = pack8(o2); }
      }
    }
  }
}

__device__ __forceinline__ void mlstm_item(const Params& p, int e, int item, const bf16_t* zm, const float* gates, bf16_t* hm, char* smem) {
  const int tidq = tid_(); const int gdq = gdim_(); const int bidq = bid_(); (void)gdq; (void)bidq;
  OPQ(zm); OPQ(gates); OPQ(hm);
  const int eh = item & 1, hh = (item >> 1) & 3, b = (item >> 3) & 15, dir = item >> 7;
  const int tid = tidq, lane = tid & 63, w = tid >> 6, fr = lane & 15, fq = lane >> 4;
  bf16_t* Vt = (bf16_t*)smem;
  bf16_t* Kt = (bf16_t*)(smem + 11520);
  bf16_t* Kn = (bf16_t*)(smem + 11520);
  bf16_t* Ct = (bf16_t*)(smem + 29952);
  bf16_t* Ps = (bf16_t*)(smem + 51712);
  float* fu = (float*)(smem + 60928);
  float* fM = fu + 64;
  float* fb = fu + 128;
  for (int i = tid; i < 80 * 136 / 2; i += 256) ((unsigned*)Ct)[i] = 0u;
  for (int i = tid; i < 16 * 72; i += 256) Vt[64 * 72 + i] = (i < 72) ? (bf16_t)0x3F80 : (bf16_t)0;
  f32x4 acc[2][5];
#pragma unroll
  for (int i = 0; i < 2; ++i)
#pragma unroll
    for (int j = 0; j < 5; ++j) acc[i][j] = (f32x4){0.f, 0.f, 0.f, 0.f};
  float m = 0.f;
  const float gbi = p.ml_gate_b[e * 16 + dir * 8 + hh], gbf = p.ml_gate_b[e * 16 + dir * 8 + 4 + hh];
  const int tq = 16 * w + fr;
  int rbase = 0, rstep = 1;
  auto setrow = [&](int c) {
    const bool isctx = c < 4;
    const int cc = isctx ? c : c - 4, len = isctx ? 256 : 2048, base = isctx ? ML + b * 256 : b * 2048;
    rbase = dir ? base + len - 1 - cc * 64 : base + cc * 64;
    rstep = dir ? -1 : 1;
  };
#define MROW(pp) (rbase + rstep * (pp))
  u32x4 vv[2], kv[4];
  bf16x8 qfn[4];
  float gli = 0.f, gfr = 0.f;
  auto prefetch = [&](int c) {
    setrow(c);
#pragma unroll
    for (int i = 0; i < 2; ++i) { const int s = lane, e8 = (w * 2 + i) * 8; vv[i] = *(const GL u32x4*)(zm + (size_t)MROW(s) * 2048 + 1024 + hh * 128 + eh * 64 + e8); }
#pragma unroll
    for (int i = 0; i < 4; ++i) { const int s = lane, d8 = (w * 4 + i) * 8; kv[i] = *(const GL u32x4*)(zm + (size_t)MROW(s) * 2048 + 512 + hh * 128 + d8); }
#pragma unroll
    for (int ks = 0; ks < 4; ++ks) qfn[ks] = *(const GL bf16x8*)(zm + (size_t)MROW(tq) * 2048 + hh * 128 + ks * 32 + fq * 8);
    if (w == 0) { const float* g = gates + (size_t)MROW(lane) * 16; gli = g[dir * 4 + hh]; gfr = g[8 + dir * 4 + hh]; }
  };
  prefetch(0);
  __syncthreads();
  for (int c = 0; c < 36; ++c) {
    setrow(c);
    if (w == 0) {
      const float li = gli + gbi;
      const float fraw = gfr + gbf;
      const float lf = fminf(fraw, 0.f) - log1pf(expf(-fabsf(fraw)));
      float bc = lf;
#pragma unroll
      for (int o = 1; o < 64; o <<= 1) { const float t = __shfl_up(bc, o); if (lane >= o) bc += t; }
      const float u = li - bc;
      float pm = u;
#pragma unroll
      for (int o = 1; o < 64; o <<= 1) { const float t = __shfl_up(pm, o); if (lane >= o) pm = fmaxf(pm, t); }
      fu[lane] = u; fM[lane] = fmaxf(m, pm); fb[lane] = bc;
    }
#pragma unroll
    for (int i = 0; i < 2; ++i) {
      const int s = lane, e8 = (w * 2 + i) * 8;
      const unsigned uu[4] = {vv[i].x, vv[i].y, vv[i].z, vv[i].w};
#pragma unroll
      for (int j = 0; j < 4; ++j) { Vt[(e8 + 2 * j) * 72 + s] = (bf16_t)(uu[j] & 0xffffu); Vt[(e8 + 2 * j + 1) * 72 + s] = (bf16_t)(uu[j] >> 16); }
    }
#pragma unroll
    for (int i = 0; i < 4; ++i) { const int s = lane, d8 = (w * 4 + i) * 8; *(u32x4*)(Kn + s * 136 + d8) = kv[i]; }
    bf16x8 qf[4];
#pragma unroll
    for (int ks = 0; ks < 4; ++ks) qf[ks] = qfn[ks];
    __syncthreads();
    const float M63 = fM[63];
    const float Mt = fM[tq];
#pragma unroll
    for (int ni = 0; ni < 4; ++ni) {
      f32x4 sa = {0.f, 0.f, 0.f, 0.f};
#pragma unroll
      for (int ks = 0; ks < 4; ++ks) {
        const bf16x8 kfr = *(const bf16x8*)(Kn + (ni * 16 + fr) * 136 + ks * 32 + fq * 8);
        sa = mfma16(kfr, qf[ks], sa);
      }
      const int s0 = ni * 16 + fq * 4;
      const f32x4 u4 = *(const f32x4*)(fu + s0);
      f32x4 pv;
#pragma unroll
      for (int j = 0; j < 4; ++j) pv[j] = (s0 + j <= tq) ? sa[j] * __expf(u4[j] - Mt) : 0.f;
      *(u32x2*)(Ps + tq * 72 + s0) = pk4(pv);
    }
    __syncthreads();
#pragma unroll
    for (int i = 0; i < 4; ++i) {
      const int s = lane, d8 = (w * 4 + i) * 8;
      const float wk = __expf(fu[s] - M63);
      float kf[8];
      unpack8(kv[i], kf);
#pragma unroll
      for (int j = 0; j < 8; ++j) Kt[(d8 + j) * 72 + s] = f2bf(kf[j] * wk);
    }
    const int orow = MROW(tq);
    if (c + 1 < 36) prefetch(c + 1);
    f32x4 aC[5], aP[5];
#pragma unroll
    for (int ni = 0; ni < 5; ++ni) { aC[ni] = (f32x4){0.f, 0.f, 0.f, 0.f}; aP[ni] = (f32x4){0.f, 0.f, 0.f, 0.f}; }
#pragma unroll
    for (int ni = 0; ni < 5; ++ni)
#pragma unroll
      for (int ks = 0; ks < 4; ++ks) {
        const bf16x8 cf = *(const bf16x8*)(Ct + (ni * 16 + fr) * 136 + ks * 32 + fq * 8);
        aC[ni] = mfma16(cf, qf[ks], aC[ni]);
      }
#pragma unroll
    for (int ks = 0; ks < 2; ++ks) {
      const bf16x8 pf = *(const bf16x8*)(Ps + tq * 72 + ks * 32 + fq * 8);
#pragma unroll
      for (int ni = 0; ni < 5; ++ni) {
        const bf16x8 vf = *(const bf16x8*)(Vt + (ni * 16 + fr) * 72 + ks * 32 + fq * 8);
        aP[ni] = mfma16(vf, pf, aP[ni]);
      }
    }
    {
      const float wprev = __expf(m - Mt);
      const float dval = wprev * aC[4][0] + aP[4][0];
      const float den = __shfl(dval, fr);
      const float dn = fmaxf(fabsf(den), __expf(-(fb[tq] + Mt)));
      const float inv = 1.f / dn;
      bf16_t* ho = hm + ((size_t)dir * MT + orow) * 512 + hh * 128 + eh * 64 + fq * 4;
#pragma unroll
      for (int ni = 0; ni < 4; ++ni) {
        const f32x4 hv = (aC[ni] * wprev + aP[ni]) * inv;
        *(GL u32x2*)(ho + ni * 16) = pk4(hv);
      }
    }
    const float bend = fb[63];
    __syncthreads();
    const float keep = __expf(m - M63);
#pragma unroll
    for (int mi = 0; mi < 2; ++mi)
#pragma unroll
      for (int ni = 0; ni < 5; ++ni) acc[mi][ni] *= keep;
#pragma unroll
    for (int ks = 0; ks < 2; ++ks) {
      bf16x8 vf[5];
#pragma unroll
      for (int ni = 0; ni < 5; ++ni) vf[ni] = *(const bf16x8*)(Vt + (ni * 16 + fr) * 72 + ks * 32 + fq * 8);
#pragma unroll
      for (int mi = 0; mi < 2; ++mi) {
        const bf16x8 kf = *(const bf16x8*)(Kt + (32 * w + mi * 16 + fr) * 72 + ks * 32 + fq * 8);
#pragma unroll
        for (int ni = 0; ni < 5; ++ni) acc[mi][ni] = mfma16(kf, vf[ni], acc[mi][ni]);
      }
    }
#pragma unroll
    for (int mi = 0; mi < 2; ++mi)
#pragma unroll
      for (int ni = 0; ni < 5; ++ni) *(u32x2*)(Ct + (ni * 16 + fr) * 136 + 32 * w + mi * 16 + fq * 4) = pk4(acc[mi][ni]);
    m = bend + M63;
    __syncthreads();
  }
#undef MROW
}

__device__ __forceinline__ void ph_mlstm_post(const Params& p, int e, const bf16_t* zm, const bf16_t* hm, bf16_t* mix) {
  const int tidq = tid_(); const int gdq = gdim_(); const int bidq = bid_(); (void)gdq; (void)bidq;
  OPQ(zm); OPQ(hm); OPQ(mix);
  const int lane = tidq & 63, c = lane * 8;
  float nw_[8];
#pragma unroll
  for (int i = 0; i < 8; ++i) nw_[i] = p.ml_norm_w[e * 512 + c + i];
  constexpr int R = 4;
  const int nw = gdq * 4;
  for (int row0 = bidq * 4 + (tidq >> 6); row0 < MT; row0 += nw * R) {
    u32x4 ua[R], ub[R], uo[R];
#pragma unroll
    for (int j = 0; j < R; ++j) {
      const int row = row0 + j * nw;
      if (row < MT) {
        ua[j] = *(const GL u32x4*)(hm + (size_t)row * 512 + c);
        ub[j] = *(const GL u32x4*)(hm + ((size_t)MT + row) * 512 + c);
        uo[j] = *(const GL u32x4*)(zm + (size_t)row * 2048 + 1536 + c);
      }
    }
#pragma unroll
    for (int j = 0; j < R; ++j) {
      const int row = row0 + j * nw;
      if (row < MT) {
        float a[8], b2[8], og[8], o[8];
        unpack8(ua[j], a); unpack8(ub[j], b2); unpack8(uo[j], og);
        float ss = 0.f;
#pragma unroll
        for (int i = 0; i < 8; ++i) { a[i] += b2[i]; ss += a[i] * a[i]; }
        ss += __shfl_xor(ss, 1); ss += __shfl_xor(ss, 2); ss += __shfl_xor(ss, 4); ss += __shfl_xor(ss, 8);
        const float rstd = rsqrtf(ss * (1.f / 128.f) + 1e-6f);
#pragma unroll
        for (int i = 0; i < 8; ++i) o[i] = a[i] * rstd * nw_[i] * sigm(og[i]);
        *(GL u32x4*)(mix + (size_t)row * 1024 + c) = pack8(o);
      }
    }
  }
}

__device__ __forceinline__ void ph_rwkv_prep(const Params& p, int e, const bf16_t* zw, bf16_t* zr, bf16_t* alin) {
  const int tidq = tid_(); const int gdq = gdim_(); const int bidq = bid_(); (void)gdq; (void)bidq;
  OPQ(zw); OPQ(zr); OPQ(alin);
  const int lane = tidq & 63;
  const float* mu = p.rw_mu + e * 1920;
  const int nw = gdq * 4;
  for (int row = bidq * 4 + (tidq >> 6); row < MT; row += nw) {
    int t, len;
    if (row < ML) { t = row & 2047; len = 2048; } else { t = (row - ML) & 255; len = 256; }
    const bool hp = t > 0, hn = t < len - 1;
    u32x4 uz[4], up[4], un[4];
#pragma unroll
    for (int q = 0; q < 4; ++q) {
      const int vi = lane + 64 * q;
      if (vi < 240) {
        const int col = vi * 8;
        uz[q] = *(const GL u32x4*)(zw + (size_t)row * 1920 + col);
        up[q] = (u32x4){0u, 0u, 0u, 0u}; un[q] = (u32x4){0u, 0u, 0u, 0u};
        if (hp) up[q] = *(const GL u32x4*)(zw + (size_t)(row - 1) * 1920 + col);
        if (hn) un[q] = *(const GL u32x4*)(zw + (size_t)(row + 1) * 1920 + col);
      }
    }
#pragma unroll
    for (int q = 0; q < 4; ++q) {
      const int vi = lane + 64 * q;
      if (vi < 240) {
        const int col = vi * 8;
        float z[8], zp[8], zn[8], o[8];
        unpack8(uz[q], z); unpack8(up[q], zp); unpack8(un[q], zn);
        const f32x4 m0 = *(const GL f32x4*)(mu + col), m1 = *(const GL f32x4*)(mu + col + 4);
#pragma unroll
        for (int i = 0; i < 8; ++i) {
          const float mm = i < 4 ? m0[i & 3] : m1[i & 3];
          float v = z[i] + mm * (0.5f * (zp[i] + zn[i]) - z[i]);
          if (col >= 1536 && col < 1664) v = tanhf(v);
          else if (col >= 1792) v = sigm(v);
          o[i] = v;
        }
        if (col < 1536) *(GL u32x4*)(zr + (size_t)row * 1536 + col) = pack8(o);
        else *(GL u32x4*)(alin + (size_t)row * 384 + (col - 1536)) = pack8(o);
      }
    }
  }
}

__device__ __forceinline__ void rwkv_item(const Params& p, int e, int item, const bf16_t* zr, const _Float16* ldp, bf16_t* alr, char* smem) {
  const int tidq = tid_(); const int gdq = gdim_(); const int bidq = bid_(); (void)gdq; (void)bidq;
  OPQ(zr); OPQ(ldp); OPQ(alr);
  const int dir = item >> 7, b = (item >> 3) & 15, hd = item & 7;
  const int tid = tidq;
  float* buf = (float*)smem;
  float* ybuf = (float*)(smem + 49152);
  const int ls = tid >> 4, lc = (tid & 15) * 4;
  const int rp = tid >> 3, sub = tid & 7;
  const f32x4 kk4 = *(const GL f32x4*)(p.rw_k_k + e * 512 + hd * 64 + lc);
  const f32x4 ka4 = *(const GL f32x4*)(p.rw_k_a + e * 512 + hd * 64 + lc);
  const _Float16* ldd = ldp + (size_t)dir * MT * 512;
  bf16_t* ald = alr + (size_t)dir * MT * 512;
  auto rowof = [&](int g) -> int {
    if (g < 256) return ML + b * 256 + (dir ? 255 - g : g);
    const int gl = g - 256;
    return b * 2048 + (dir ? 2047 - gl : gl);
  };
  u32x2 r4, k4, v4, l4, a4;
  auto gload = [&](int c) {
    const int row = rowof(c * 16 + ls);
    const bf16_t* zp = zr + (size_t)row * 1536 + hd * 64 + lc;
    r4 = *(const GL u32x2*)zp; k4 = *(const GL u32x2*)(zp + 512); v4 = *(const GL u32x2*)(zp + 1024);
    l4 = *(const GL u32x2*)(ldd + (size_t)row * 512 + hd * 64 + lc);
    a4 = *(const GL u32x2*)(ald + (size_t)row * 512 + hd * 64 + lc);
  };
  auto stage = [&](int nb) {
    float* d = buf + nb * 6 * 1024 + ls * 64 + lc;
    const f32x4 r = {bflo(r4.x), bfhi(r4.x), bflo(r4.y), bfhi(r4.y)};
    const f32x4 k = {bflo(k4.x), bfhi(k4.x), bflo(k4.y), bfhi(k4.y)};
    const f32x4 v = {bflo(v4.x), bfhi(v4.x), bflo(v4.y), bfhi(v4.y)};
    const f32x4 a = {bflo(a4.x), bfhi(a4.x), bflo(a4.y), bfhi(a4.y)};
    _Float16 lh[4]; *(u32x2*)lh = l4;
    f32x4 kk = k * kk4;
    float ss = kk[0] * kk[0] + kk[1] * kk[1] + kk[2] * kk[2] + kk[3] * kk[3];
    ss += __shfl_xor(ss, 1); ss += __shfl_xor(ss, 2); ss += __shfl_xor(ss, 4); ss += __shfl_xor(ss, 8);
    const float inv = 1.f / fmaxf(sqrtf(ss), 1e-12f);
    kk = kk * inv;
    f32x4 wv, kd, bv;
#pragma unroll
    for (int i = 0; i < 4; ++i) { wv[i] = __expf((float)lh[i]); kd[i] = k[i] * (1.f + (a[i] - 1.f) * ka4[i]); bv[i] = kk[i] * a[i]; }
    *(f32x4*)(d + 0 * 1024) = r; *(f32x4*)(d + 1 * 1024) = wv; *(f32x4*)(d + 2 * 1024) = kd;
    *(f32x4*)(d + 3 * 1024) = v; *(f32x4*)(d + 4 * 1024) = kk; *(f32x4*)(d + 5 * 1024) = bv;
  };
  f32x2 S[8];
#pragma unroll
  for (int j = 0; j < 8; ++j) S[j] = (f32x2){0.f, 0.f};
  __syncthreads();
  gload(0);
  stage(0);
  __syncthreads();
  for (int c = 0; c < 144; ++c) {
    if (c + 1 < 144) gload(c + 1);
    const float* cur = buf + (c & 1) * 6 * 1024;
    float* yb = ybuf + (c & 1) * 1024;
    {
      struct StepIn { f32x4 r0, r1, w0, w1, d0, d1, k0, k1, b0, b1; f32x2 v; };
      auto ldstep = [&](int st) -> StepIn {
        StepIn x;
        const float* q = cur + st * 64 + sub * 8;
        x.k0 = *(const f32x4*)(q + 4096); x.k1 = *(const f32x4*)(q + 4096 + 4);
        x.v = *(const f32x2*)(cur + 3072 + st * 64 + 2 * rp);
        x.d0 = *(const f32x4*)(q + 2048); x.d1 = *(const f32x4*)(q + 2048 + 4);
        x.b0 = *(const f32x4*)(q + 5120); x.b1 = *(const f32x4*)(q + 5120 + 4);
        x.w0 = *(const f32x4*)(q + 1024); x.w1 = *(const f32x4*)(q + 1024 + 4);
        x.r0 = *(const f32x4*)(q); x.r1 = *(const f32x4*)(q + 4);
        return x;
      };
      f32x2 ypend = {0.f, 0.f};
      auto dostep = [&](const StepIn& x, int st) {
        const float rr[8] = {x.r0[0], x.r0[1], x.r0[2], x.r0[3], x.r1[0], x.r1[1], x.r1[2], x.r1[3]};
        const float ww[8] = {x.w0[0], x.w0[1], x.w0[2], x.w0[3], x.w1[0], x.w1[1], x.w1[2], x.w1[3]};
        const float dd[8] = {x.d0[0], x.d0[1], x.d0[2], x.d0[3], x.d1[0], x.d1[1], x.d1[2], x.d1[3]};
        const float kk[8] = {x.k0[0], x.k0[1], x.k0[2], x.k0[3], x.k1[0], x.k1[1], x.k1[2], x.k1[3]};
        const float bb[8] = {x.b0[0], x.b0[1], x.b0[2], x.b0[3], x.b1[0], x.b1[1], x.b1[2], x.b1[3]};
        f32x2 sa0 = S[0] * kk[0], sa1 = S[1] * kk[1];
#pragma unroll
        for (int j = 2; j < 8; j += 2) { sa0 += S[j] * kk[j]; sa1 += S[j + 1] * kk[j + 1]; }
        f32x2 sa = sa0 + sa1;
        if (st > 0) {
          f32x2 yp = ypend;
          yp.x = red8(yp.x); yp.y = red8(yp.y);
          if (sub == 0) *(f32x2*)(yb + (st - 1) * 64 + 2 * rp) = yp;
        }
        sa.x = red8(sa.x); sa.y = red8(sa.y);
        f32x2 y0 = {0.f, 0.f}, y1 = {0.f, 0.f};
#pragma unroll
        for (int j = 0; j < 8; j += 2) {
          const f32x2 t0 = x.v * dd[j] - sa * bb[j], t1 = x.v * dd[j + 1] - sa * bb[j + 1];
          S[j] = S[j] * ww[j] + t0; S[j + 1] = S[j + 1] * ww[j + 1] + t1;
          y0 += S[j] * rr[j]; y1 += S[j + 1] * rr[j + 1];
        }
        ypend = y0 + y1;
      };
      StepIn xa = ldstep(0), xb;
#pragma unroll
      for (int s2 = 0; s2 < 16; s2 += 2) {
        xb = ldstep(s2 + 1);
        dostep(xa, s2);
        if (s2 + 2 < 16) xa = ldstep(s2 + 2);
        dostep(xb, s2 + 1);
      }
      {
        f32x2 yp = ypend;
        yp.x = red8(yp.x); yp.y = red8(yp.y);
        if (sub == 0) *(f32x2*)(yb + 15 * 64 + 2 * rp) = yp;
      }
    }
    if (c + 1 < 144) stage((c + 1) & 1);
    __syncthreads();
    {
      const f32x4 y4 = *(const f32x4*)(yb + ls * 64 + lc);
      *(GL u32x2*)(ald + (size_t)rowof(c * 16 + ls) * 512 + hd * 64 + lc) = pk4(y4);
    }
  }
  __syncthreads();
}

__device__ __forceinline__ void ph_rwkv_post(const Params& p, int e, const bf16_t* zr, const bf16_t* alr, const bf16_t* g, bf16_t* mix) {
  const int tidq = tid_(); const int gdq = gdim_(); const int bidq = bid_(); (void)gdq; (void)bidq;
  OPQ(zr); OPQ(alr); OPQ(g); OPQ(mix);
  const int lane = tidq & 63, c = lane * 8;
  float lw[8], lb[8], rk[8];
#pragma unroll
  for (int i = 0; i < 8; ++i) { lw[i] = p.rw_ln_w[e * 512 + c + i]; lb[i] = p.rw_ln_b[e * 512 + c + i]; rk[i] = p.rw_r_k[e * 512 + c + i]; }
  constexpr int R = 2;
  const int nw = gdq * 4;
  for (int row0 = bidq * 4 + (tidq >> 6); row0 < MT; row0 += nw * R) {
    u32x4 u0[R], u1[R], ur[R], uk[R], uv[R], ug[R];
#pragma unroll
    for (int j = 0; j < R; ++j) {
      const int row = row0 + j * nw;
      if (row < MT) {
        u0[j] = *(const GL u32x4*)(alr + (size_t)row * 512 + c);
        u1[j] = *(const GL u32x4*)(alr + ((size_t)MT + row) * 512 + c);
        ur[j] = *(const GL u32x4*)(zr + (size_t)row * 1536 + c);
        uk[j] = *(const GL u32x4*)(zr + (size_t)row * 1536 + 512 + c);
        uv[j] = *(const GL u32x4*)(zr + (size_t)row * 1536 + 1024 + c);
        ug[j] = *(const GL u32x4*)(g + (size_t)row * 512 + c);
      }
    }
#pragma unroll
    for (int j = 0; j < R; ++j) {
      const int row = row0 + j * nw;
      if (row < MT) {
        float y[8], y1[8], r[8], k[8], v[8], gg[8], o[8];
        unpack8(u0[j], y); unpack8(u1[j], y1); unpack8(ur[j], r); unpack8(uk[j], k); unpack8(uv[j], v); unpack8(ug[j], gg);
        float sm = 0.f, bs = 0.f;
#pragma unroll
        for (int i = 0; i < 8; ++i) { y[i] += y1[i]; sm += y[i]; bs += r[i] * k[i] * rk[i]; }
        sm += __shfl_xor(sm, 1); sm += __shfl_xor(sm, 2); sm += __shfl_xor(sm, 4);
        bs += __shfl_xor(bs, 1); bs += __shfl_xor(bs, 2); bs += __shfl_xor(bs, 4);
        const float mean = sm * (1.f / 64.f);
        float vs = 0.f;
#pragma unroll
        for (int i = 0; i < 8; ++i) { y[i] -= mean; vs += y[i] * y[i]; }
        vs += __shfl_xor(vs, 1); vs += __shfl_xor(vs, 2); vs += __shfl_xor(vs, 4);
        const float rstd = rsqrtf(vs * (1.f / 64.f) + 64e-5f);
#pragma unroll
        for (int i = 0; i < 8; ++i) o[i] = (y[i] * rstd * lw[i] + lb[i] + bs * v[i]) * gg[i];
        *(GL u32x4*)(mix + (size_t)row * 1024 + 512 + c) = pack8(o);
      }
    }
  }
}

__device__ __forceinline__ void ph_conv(const Params& p, int o, const bf16_t* zo, bf16_t* uc) {
  const int tidq = tid_(); const int gdq = gdim_(); const int bidq = bid_(); (void)gdq; (void)bidq;
  OPQ(zo); OPQ(uc);
  const int lane = tidq & 63, c = lane * 8;
  float cw[4][8], cb[8];
#pragma unroll
  for (int j = 0; j < 4; ++j)
#pragma unroll
    for (int i = 0; i < 8; ++i) cw[j][i] = p.lru_conv_w[(o * 4 + j) * 512 + c + i];
#pragma unroll
  for (int i = 0; i < 8; ++i) cb[i] = p.lru_conv_b[o * 512 + c + i];
  constexpr int R = 2;
  const int nw = gdq * 4;
  for (int row0 = bidq * 4 + (tidq >> 6); row0 < MT; row0 += nw * R) {
    u32x4 ux[R][4];
#pragma unroll
    for (int r = 0; r < R; ++r) {
      const int row = row0 + r * nw;
      if (row < MT) {
        int t, len;
        if (row < ML) { t = row & 2047; len = 2048; } else { t = (row - ML) & 255; len = 256; }
#pragma unroll
        for (int j = 0; j < 4; ++j) {
          const int tt = t - 1 + j;
          ux[r][j] = (u32x4){0u, 0u, 0u, 0u};
          if (tt >= 0 && tt < len) ux[r][j] = *(const GL u32x4*)(zo + (size_t)(row - 1 + j) * 2560 + c);
        }
      }
    }
#pragma unroll
    for (int r = 0; r < R; ++r) {
      const int row = row0 + r * nw;
      if (row < MT) {
        float acc[8];
#pragma unroll
        for (int i = 0; i < 8; ++i) acc[i] = cb[i];
#pragma unroll
        for (int j = 0; j < 4; ++j) {
          float x[8];
          unpack8(ux[r][j], x);
#pragma unroll
          for (int i = 0; i < 8; ++i) acc[i] += cw[j][i] * x[i];
        }
        *(GL u32x4*)(uc + (size_t)row * 512 + c) = pack8(acc);
      }
    }
  }
}

__device__ __forceinline__ void lru_item(const Params& p, int o, int item, const bf16_t* uc, const bf16_t* gates, bf16_t* hd, char* smem) {
  const int tidq = tid_(); const int gdq = gdim_(); const int bidq = bid_(); (void)gdq; (void)bidq;
  OPQ(uc); OPQ(gates); OPQ(hd);
  const int z = item >> 7, b = (item >> 3) & 15, cgp = item & 7;
  const int tid = tidq, c = tid & 63, seg = tid >> 6, ch = cgp * 64 + c;
  bf16_t* st = (bf16_t*)smem + seg * 6144;
  float* segP = (float*)(smem + 49152); float* segH = segP + 256;
  const float lam = p.lru_lambda[(o * 2 + z) * 512 + ch];
  const float kc = -8.f * log1pf(expf(-lam));
  float carry = 0.f;
  __syncthreads();
  for (int sc = 0; sc < 9; ++sc) {
    const int g0 = sc * 256 + seg * 64;
    int rbase; const int rstep = z ? -1 : 1;
    if (sc == 0) rbase = ML + b * 256 + (z ? 255 - g0 : g0);
    else { const int gl = g0 - 256; rbase = b * 2048 + (z ? 2047 - gl : gl); }
    float P = 1.f, H = 0.f, hin = 0.f;
#pragma unroll 1
    for (int pass = 0; pass < 2; ++pass) {
      if (pass == 1) H = hin;
#pragma unroll 1
      for (int half = 0; half < 2; ++half) {
        u32x4 lr[4], li[4], lu[4];
#pragma unroll
        for (int j = 0; j < 4; ++j) {
          const int q = c + 64 * j, stp = q >> 3, part = q & 7;
          const size_t row = (size_t)(rbase + rstep * (half * 32 + stp));
          const bf16_t* gp = gates + row * 2048 + z * 1024 + cgp * 64 + part * 8;
          lr[j] = *(const GL u32x4*)gp; li[j] = *(const GL u32x4*)(gp + 512);
          lu[j] = *(const GL u32x4*)(uc + row * 512 + cgp * 64 + part * 8);
        }
        __syncthreads();
#pragma unroll
        for (int j = 0; j < 4; ++j) {
          const int q = c + 64 * j;
          *(u32x4*)(st + q * 8) = lr[j]; *(u32x4*)(st + 2048 + q * 8) = li[j]; *(u32x4*)(st + 4096 + q * 8) = lu[j];
        }
        __syncthreads();
#pragma unroll 8
        for (int i = 0; i < 32; ++i) {
          const float rg = bf2f(st[i * 64 + c]), ig = bf2f(st[2048 + i * 64 + c]), u = bf2f(st[4096 + i * 64 + c]);
          const float la = kc * rg, a = __expf(la);
          const float t2 = 2.f * la;
          const float om = (t2 > -0.02f) ? -t2 * (1.f + t2 * (0.5f + t2 * 0.16666667f)) : 1.f - a * a;
          const float x = __builtin_amdgcn_sqrtf(fmaxf(om, 0.f)) * ig * u;
          H = a * H + x;
          if (pass == 0) P *= a;
          else hd[((size_t)z * MT + (size_t)(rbase + rstep * (half * 32 + i))) * 512 + ch] = f2bf(H);
        }
      }
      if (pass == 0) {
        segP[seg * 64 + c] = P; segH[seg * 64 + c] = H;
        __syncthreads();
        float h = carry;
#pragma unroll
        for (int s2 = 0; s2 < 4; ++s2) { if (s2 == seg) hin = h; h = segP[s2 * 64 + c] * h + segH[s2 * 64 + c]; }
        carry = h;
      }
    }
    __syncthreads();
  }
}
__device__ __forceinline__ void ph_lru_post(const bf16_t* hd, bf16_t* zo) {
  const int tidq = tid_(); const int gdq = gdim_(); const int bidq = bid_(); (void)gdq; (void)bidq;
  OPQ(hd); OPQ(zo);
  const int lane = tidq & 63, c = lane * 8;
  constexpr int R = 4;
  const int nw = gdq * 4;
  for (int row0 = bidq * 4 + (tidq >> 6); row0 < MT; row0 += nw * R) {
    u32x4 ua[R], ub[R], ug[R];
#pragma unroll
    for (int j = 0; j < R; ++j) {
      const int row = row0 + j * nw;
      if (row < MT) {
        ua[j] = *(const GL u32x4*)(hd + (size_t)row * 512 + c);
        ub[j] = *(const GL u32x4*)(hd + ((size_t)MT + row) * 512 + c);
        ug[j] = *(const GL u32x4*)(zo + (size_t)row * 2560 + 512 + c);
      }
    }
#pragma unroll
    for (int j = 0; j < R; ++j) {
      const int row = row0 + j * nw;
      if (row < MT) {
        float a[8], b2[8], g[8], o[8];
        unpack8(ua[j], a); unpack8(ub[j], b2); unpack8(ug[j], g);
#pragma unroll
        for (int i = 0; i < 8; ++i) {
          const float x = g[i];
          const float ge = 0.5f * x * (1.f + tanhf(0.7978845608028654f * (x + 0.044715f * x * x * x)));
          o[i] = (a[i] + b2[i]) * ge;
        }
        *(GL u32x4*)(zo + (size_t)row * 2560 + c) = pack8(o);
      }
    }
  }
}

__device__ __forceinline__ void attn_item(const Params& p, int o, int item, int local, bf16_t* zo, char* smem) {
  const int tidq = tid_(); const int gdq = gdim_(); const int bidq = bid_(); (void)gdq; (void)bidq;
  OPQ(zo);
  const int tid = tidq, lane = tid & 63, w = tid >> 6, fr = lane & 15, fq = lane >> 4;
  constexpr int VS = 524;
  bf16_t* Vt = (bf16_t*)smem;
  float* rpbs = (float*)(smem + 67072);
  int h, b, r = 0, r0 = 0, qrow, qcol = 0, band0 = 0;
  if (local) {
    h = item & 7; r = (item >> 3) & 31; b = item >> 8;
    r0 = min(max(r - 4, 0), 24);
    qcol = w * 16 + fr;
    band0 = min(max(w * 16 - 8, 0), 32);
    qrow = b * 2048 + r * 64 + qcol;
  } else {
    h = item & 7; b = (item >> 3) & 15;
    const int g4 = item >> 7;
    qrow = ML + b * 256 + g4 * 64 + w * 16 + fr;
  }
  const bf16_t* qp = zo + (size_t)qrow * 2560 + 1024 + h * 64;
  const bf16x8 qf0 = *(const GL bf16x8*)(qp + fq * 8), qf1 = *(const GL bf16x8*)(qp + 32 + fq * 8);
  float m1 = -1e30f, lsum = 0.f;
  f32x4 O[4];
#pragma unroll
  for (int i = 0; i < 4; ++i) O[i] = (f32x4){0.f, 0.f, 0.f, 0.f};
  __syncthreads();
  if (local) {
#pragma unroll 4
    for (int i = 0; i < 16; ++i) {
      const int tok = lane + 64 * (i & 7), e8 = (w * 2 + (i >> 3)) * 8;
      const int row = b * 2048 + (r0 + (tok >> 6)) * 64 + (tok & 63);
      const u32x4 v = *(const GL u32x4*)(zo + (size_t)row * 2560 + 2048 + h * 64 + e8);
      const unsigned uu[4] = {v.x, v.y, v.z, v.w};
#pragma unroll
      for (int j = 0; j < 4; ++j) { Vt[(e8 + 2 * j) * VS + tok] = (bf16_t)(uu[j] & 0xffffu); Vt[(e8 + 2 * j + 1) * VS + tok] = (bf16_t)(uu[j] >> 16); }
    }
    for (int i = tid; i < 465; i += 256) rpbs[i] = p.na_rpb[(size_t)(o * 8 + h) * 465 + i];
    __syncthreads();
    f32x4 sc[16];
    const int win0 = min(max(qcol - 8, 0), 48);
    float mx = -1e30f;
#pragma unroll
    for (int ni = 0; ni < 16; ++ni) {
      const int kr = ni >> 1, j0 = (ni & 1) * 16;
      const bf16_t* kp = zo + (size_t)(b * 2048 + (r0 + kr) * 64 + band0 + j0 + fr) * 2560 + 1536 + h * 64;
      const bf16x8 k0 = *(const GL bf16x8*)(kp + fq * 8), k1 = *(const GL bf16x8*)(kp + 32 + fq * 8);
      f32x4 s = {0.f, 0.f, 0.f, 0.f};
      s = mfma16(k0, qf0, s); s = mfma16(k1, qf1, s);
      const int drow = r0 + kr - r + 7;
#pragma unroll
      for (int j = 0; j < 4; ++j) {
        const int kcol = band0 + j0 + fq * 4 + j;
        const int rel = kcol - win0;
        const int dcol = min(max(kcol - qcol + 15, 0), 30);
        const float val = (rel >= 0 && rel < 16) ? s[j] * 0.125f + rpbs[drow * 31 + dcol] : -1e30f;
        s[j] = val; mx = fmaxf(mx, val);
      }
      sc[ni] = s;
    }
    mx = fmaxf(mx, __shfl_xor(mx, 16)); mx = fmaxf(mx, __shfl_xor(mx, 32));
    m1 = mx;
#pragma unroll
    for (int a = 0; a < 8; ++a) {
      f32x4 p0, p1;
#pragma unroll
      for (int j = 0; j < 4; ++j) { p0[j] = __expf(sc[2 * a][j] - m1); p1[j] = __expf(sc[2 * a + 1][j] - m1); lsum += p0[j] + p1[j]; }
      const u32x2 a0 = pk4(p0), a1 = pk4(p1);
      const u32x4 pu = {a0.x, a0.y, a1.x, a1.y};
      const bf16x8 pf = *(const bf16x8*)&pu;
#pragma unroll
      for (int ne = 0; ne < 4; ++ne) {
        const bf16_t* vp = Vt + (ne * 16 + fr) * VS + a * 64 + band0 + fq * 4;
        const u32x2 lo = *(const u32x2*)vp, hi = *(const u32x2*)(vp + 16);
        const u32x4 vu = {lo.x, lo.y, hi.x, hi.y};
        O[ne] = mfma16(*(const bf16x8*)&vu, pf, O[ne]);
      }
    }
    __syncthreads();
  }
#pragma unroll 4
  for (int i = 0; i < 8; ++i) {
    const int tok = lane + 64 * (i & 3), e8 = (w * 2 + (i >> 2)) * 8;
    const u32x4 v = *(const GL u32x4*)(zo + (size_t)(ML + b * 256 + tok) * 2560 + 2048 + h * 64 + e8);
    const unsigned uu[4] = {v.x, v.y, v.z, v.w};
#pragma unroll
    for (int j = 0; j < 4; ++j) { Vt[(e8 + 2 * j) * VS + tok] = (bf16_t)(uu[j] & 0xffffu); Vt[(e8 + 2 * j + 1) * VS + tok] = (bf16_t)(uu[j] >> 16); }
  }
  __syncthreads();
  {
    f32x4 sc[16];
    float mx = -1e30f;
#pragma unroll
    for (int ni = 0; ni < 16; ++ni) {
      const bf16_t* kp = zo + (size_t)(ML + b * 256 + ni * 16 + fr) * 2560 + 1536 + h * 64;
      const bf16x8 k0 = *(const GL bf16x8*)(kp + fq * 8), k1 = *(const GL bf16x8*)(kp + 32 + fq * 8);
      f32x4 s = {0.f, 0.f, 0.f, 0.f};
      s = mfma16(k0, qf0, s); s = mfma16(k1, qf1, s);
#pragma unroll
      for (int j = 0; j < 4; ++j) { s[j] *= 0.125f; mx = fmaxf(mx, s[j]); }
      sc[ni] = s;
    }
    mx = fmaxf(mx, __shfl_xor(mx, 16)); mx = fmaxf(mx, __shfl_xor(mx, 32));
    const float m2 = fmaxf(m1, mx);
    const float alpha = __expf(m1 - m2);
    lsum *= alpha;
#pragma unroll
    for (int ne = 0; ne < 4; ++ne) O[ne] *= alpha;
#pragma unroll
    for (int a = 0; a < 8; ++a) {
      f32x4 p0, p1;
#pragma unroll
      for (int j = 0; j < 4; ++j) { p0[j] = __expf(sc[2 * a][j] - m2); p1[j] = __expf(sc[2 * a + 1][j] - m2); lsum += p0[j] + p1[j]; }
      const u32x2 a0 = pk4(p0), a1 = pk4(p1);
      const u32x4 pu = {a0.x, a0.y, a1.x, a1.y};
      const bf16x8 pf = *(const bf16x8*)&pu;
#pragma unroll
      for (int ne = 0; ne < 4; ++ne) {
        const bf16_t* vp = Vt + (ne * 16 + fr) * VS + a * 32 + fq * 4;
        const u32x2 lo = *(const u32x2*)vp, hi = *(const u32x2*)(vp + 16);
        const u32x4 vu = {lo.x, lo.y, hi.x, hi.y};
        O[ne] = mfma16(*(const bf16x8*)&vu, pf, O[ne]);
      }
    }
  }
  lsum += __shfl_xor(lsum, 16); lsum += __shfl_xor(lsum, 32);
  const float inv = 1.f / lsum;
  bf16_t* op = zo + (size_t)qrow * 2560 + 1024 + h * 64 + fq * 4;
#pragma unroll
  for (int ne = 0; ne < 4; ++ne) *(GL u32x2*)(op + ne * 16) = pk4(O[ne] * inv);
  __syncthreads();
}


#define XB_TMO      128
#define XB_XCNT(j)  (256  + 64 * (j))
#define XB_XSUB(j)  (1280 + 64 * (j))
#define XB_XGEN(j)  (2304 + 64 * (j))
#define XB_TOP      3328
#define XB_TOPGEN   3392
#define XCD_BAR_WORDS 3456
#define XB_SPIN_CAP (1u << 18)
#define LAS __attribute__((address_space(3)))
__device__ __forceinline__ unsigned xb_ld(unsigned* p)              { return __hip_atomic_load(p, __ATOMIC_RELAXED, __HIP_MEMORY_SCOPE_AGENT); }
__device__ __forceinline__ unsigned xb_add(unsigned* p, unsigned v) { return __hip_atomic_fetch_add(p, v, __ATOMIC_RELAXED, __HIP_MEMORY_SCOPE_AGENT); }
__device__ __forceinline__ unsigned xb_xcc_id() { return (unsigned)__builtin_amdgcn_s_getreg((3 << 11) | 20) & 0xFu; }
#define XB_SPIN(cond, bar) do { unsigned _sp = 0; while (cond) { __builtin_amdgcn_s_sleep(1); \
    if ((++_sp & 255u) == 0u) { if (xb_ld(&(bar)[XB_TMO])) break; if (_sp > XB_SPIN_CAP) { atomicAdd(&(bar)[XB_TMO], 1u); break; } } } } while (0)
struct XcdBarrier { unsigned* bar; unsigned x; volatile LAS unsigned* st; };
__device__ __forceinline__ XcdBarrier xcd_barrier_post(unsigned* bar, volatile LAS unsigned* st) {
  XcdBarrier b; b.bar = bar; b.x = xb_xcc_id(); b.st = st;
  if (threadIdx.x == 0) (void)xb_add(&bar[XB_XCNT(b.x)], 1u);
  return b;
}
__device__ __forceinline__ void xcd_barrier_complete(unsigned* bar, unsigned x, unsigned& nloc, unsigned& nx) {
  const unsigned G = gridDim.x * gridDim.y * gridDim.z;
  unsigned sum, cnt, mine, sp = 0u;
  for (;;) {
    sum = 0u; cnt = 0u; mine = 0u;
#pragma unroll
    for (unsigned j = 0; j < 16; ++j) { const unsigned c = xb_ld(&bar[XB_XCNT(j)]); sum += c; cnt += (c > 0u) ? 1u : 0u; mine = (j == x) ? c : mine; }
    if (sum == G) break;
    __builtin_amdgcn_s_sleep(1);
    if ((++sp & 255u) == 0u) { if (xb_ld(&bar[XB_TMO])) break; if (sp > XB_SPIN_CAP) { atomicAdd(&bar[XB_TMO], 1u); break; } }
  }
  nloc = mine > 0u ? mine : 1u; nx = cnt > 0u ? cnt : 1u;
}
__device__ __forceinline__ void xcd_barrier(const XcdBarrier& b) {
  asm volatile("s_waitcnt vmcnt(0)" ::: "memory");
  __syncthreads();
  if (threadIdx.x == 0) {
    unsigned* bar = b.bar;
    __builtin_amdgcn_s_waitcnt(0);
    unsigned nloc = b.st[0], nx = b.st[1];
    if (nloc == 0u) { xcd_barrier_complete(bar, b.x, nloc, nx); b.st[0] = nloc; b.st[1] = nx; }
    const unsigned old = xb_add(&bar[XB_XSUB(b.x)], 1u);
    const unsigned gen = old / nloc;
    if (old + 1u == (gen + 1u) * nloc) {
      __builtin_amdgcn_fence(__ATOMIC_RELEASE, "agent");
      asm volatile("s_waitcnt vmcnt(0)" ::: "memory");
      const unsigned og = xb_add(&bar[XB_TOP], 1u);
      const unsigned tg = og / nx;
      if (og + 1u == (tg + 1u) * nx) xb_add(&bar[XB_TOPGEN], 1u);
      else XB_SPIN(xb_ld(&bar[XB_TOPGEN]) == tg, bar);
      __builtin_amdgcn_fence(__ATOMIC_ACQUIRE, "agent");
      xb_add(&bar[XB_XGEN(b.x)], 1u);
      asm volatile("s_waitcnt vmcnt(0)" ::: "memory");
    } else {
      XB_SPIN(xb_ld(&bar[XB_XGEN(b.x)]) == gen, bar);
      __builtin_amdgcn_fence(__ATOMIC_ACQUIRE, "agent");
      asm volatile("s_waitcnt vmcnt(0)" ::: "memory");
    }
  }
  __syncthreads();
}
#define WSN (opq_(*(char* const volatile*)&p.ws))
#define OUTN (opq_(*(float* const volatile*)&p.out))
#define XN_ (opq_(*(const float* const volatile*)&p.x))
#define CTXN_ (opq_(*(const float* const volatile*)&p.ctx))
#define B_mod ((float*)(WSN + OFF_MOD))
#define B_gates ((float*)(WSN + OFF_GATES))
#define B_WTIN ((const bf16_t*)(WSN + OFF_WTIN))
#define B_WTOUT ((const bf16_t*)(WSN + OFF_WTOUT))
#define B_WT1 ((const bf16_t*)(WSN + OFF_WT1))
#define B_WT2 ((const bf16_t*)(WSN + OFF_WT2))
#define B_xn ((bf16_t*)(WSN + OFF_ARENA))
#define B_zm ((bf16_t*)(WSN + OFF_ARENA + 2 * SU))
#define B_zw ((bf16_t*)(WSN + OFF_ARENA + 6 * SU))
#define B_mix ((bf16_t*)(WSN + OFF_ARENA + 9 * SU + 3 * (SU / 4)))
#define B_hm ((bf16_t*)(WSN + OFF_ARENA))
#define B_zr ((bf16_t*)(WSN + OFF_ARENA))
#define B_alin ((bf16_t*)(WSN + OFF_ARENA + 3 * SU))
#define B_ldp ((_Float16*)(WSN + OFF_ARENA + 3 * SU + 3 * (SU / 4)))
#define B_alr ((bf16_t*)(WSN + OFF_ARENA + 5 * SU + 3 * (SU / 4)))
#define B_gg ((bf16_t*)(WSN + OFF_ARENA + 7 * SU + 3 * (SU / 4)))
#define B_zo ((bf16_t*)(WSN + OFF_ARENA + 2 * SU))
#define B_uc ((bf16_t*)(WSN + OFF_ARENA + 7 * SU))
#define B_lg ((bf16_t*)(WSN + OFF_ARENA + 8 * SU))
#define B_hd ((bf16_t*)(WSN + OFF_ARENA))
#define B_uh ((bf16_t*)(WSN + OFF_ARENA + 2 * SU))
#define B_AR (WSN + OFF_ARENA)
#define B_ws (WSN)
__global__ void __launch_bounds__(256, 2) mega(Params pk) {
  cg::grid_group grid = cg::this_grid();
  if (blockDim.x == 7) grid.sync();
  __shared__ __attribute__((aligned(16))) char smem[73728];
  __shared__ Params sp_;
  __shared__ uint4 xb_words;
  if (threadIdx.x == 0) { sp_ = pk; xb_words = make_uint4(0u, 0u, 0u, 0u); }
  __syncthreads();
  const Params& p = sp_;
  XcdBarrier xb = xcd_barrier_post((unsigned*)(pk.ws + OFF_BAR), (volatile LAS unsigned*)&xb_words);
  const int NOJ = 1 << 30;

  if (blockIdx.x == 0 && threadIdx.x < 64) ((unsigned*)WSN)[threadIdx.x] = 0u;
  ph_prologue(p, smem);
  GSYNC();
  for (int l = 0; l < 4; ++l) {
    const bool last = (l == 3);
    const int Mrows = last ? ML : MT;
    ph_convert(p, l, smem);
    ph_norm(p, l, 0, MT, B_xn, l == 0);
    GSYNC();
    if (SKIP_EVEN && (l & 1) == 0) {
    } else if ((l & 1) == 0) {
      const int e = l >> 1;
      if (EVMASK & 1) gemm_phase(B_xn, 1024, NOJ, 0, B_WTIN, 1024, MT, 3984, 1024, EpiInEven{B_zm, B_zw, B_gates}, smem);
      GSYNC();
      if (EVMASK & 2) ph_rope(p, B_zm);
      GSYNC();
      if (!SKIP_MLSTM) for (int it = blockIdx.x; it < 256; it += gridDim.x) mlstm_item(p, e, it, B_zm, B_gates, B_hm, smem);
      GSYNC();
      if (EVMASK & 4) ph_mlstm_post(p, e, B_zm, B_hm, B_mix);
      GSYNC();
      if (EVMASK & 8) ph_rwkv_prep(p, e, B_zw, B_zr, B_alin);
      GSYNC();
      if ((EVMASK & 16)) for (int d = 0; d < 2; ++d) {
        gemm_phase(B_alin + d * 64, 384, NOJ, 0, (const bf16_t*)(B_ws + OFF_WUP) + d * 512 * 64, 64, MT, 512, 64,
                   EpiLd{B_ldp + (size_t)d * MT * 512, p.rw_w0 + (e * 2 + d) * 512}, smem);
        gemm_phase(B_alin + 128 + d * 64, 384, NOJ, 0, (const bf16_t*)(B_ws + OFF_AUP) + d * 512 * 64, 64, MT, 512, 64,
                   EpiAlr{B_alr + (size_t)d * MT * 512, p.rw_a0 + (e * 2 + d) * 512}, smem);
      }
      if ((EVMASK & 16)) gemm_phase(B_alin + 256, 384, NOJ, 0, (const bf16_t*)(B_ws + OFF_GUP), 128, MT, 512, 128, EpiStore{B_gg, 512}, smem);
      GSYNC();
      if (!SKIP_RWKV) for (int it = blockIdx.x; it < 256; it += gridDim.x) rwkv_item(p, e, it, B_zr, B_ldp, B_alr, smem);
      GSYNC();
      if (EVMASK & 32) ph_rwkv_post(p, e, B_zr, B_alr, B_gg, B_mix);
      GSYNC();
      if (EVMASK & 64) gemm_phase(B_mix, 1024, NOJ, 0, B_WTOUT, 1024, Mrows, 1024, 1024, EpiResid{OUTN, (float*)(B_ws + OFF_HCTX), B_mod + (size_t)l * 17 * 6144 + 2048, (l == 0 ? XN_ : (const float*)OUTN), (l == 0 ? CTXN_ : (const float*)(B_ws + OFF_HCTX))}, smem);
      GSYNC();
    } else if (!SKIP_ODD) {
      const int o = l >> 1;
      gemm_phase(B_xn, 1024, NOJ, 0, B_WTIN, 1024, MT, 2560, 1024, EpiStore{B_zo, 2560}, smem);
      GSYNC();
      ph_conv(p, o, B_zo, B_uc);
      GSYNC();
      gemm_phase_t<4>(B_uc, 512, NOJ, 0, (const bf16_t*)(B_ws + OFF_GWT), 64, MT, 2048, 64, EpiGates{B_lg, p.lru_gate_b + o * 2048}, smem, 256);
      GSYNC();
      {
        const int n_lru = 256, n_na = 4096, n_ca = last ? 0 : 512;
        __shared__ int s_it;
        unsigned* ctr = (unsigned*)WSN + 16 * o;
        for (;;) {
          __syncthreads();
          if (threadIdx.x == 0) s_it = (int)atomicAdd(ctr, 1u);
          __syncthreads();
          const int it = s_it;
          if (it >= n_lru + n_na + n_ca) break;
          if (it < n_lru) lru_item(p, o, it, B_uc, B_lg, B_hd, smem);
          else if (it < n_lru + n_na) attn_item(p, o, it - n_lru, 1, B_zo, smem);
          else attn_item(p, o, it - n_lru - n_na, 0, B_zo, smem);
        }
      }
      GSYNC();
      ph_lru_post(B_hd, B_zo);
      GSYNC();
      gemm_phase(B_zo, 2560, 512, 512, B_WTOUT, 1024, Mrows, 1024, 1024, EpiResid{OUTN, (float*)(B_ws + OFF_HCTX), B_mod + (size_t)l * 17 * 6144 + 2048, (l == 0 ? XN_ : (const float*)OUTN), (l == 0 ? CTXN_ : (const float*)(B_ws + OFF_HCTX))}, smem);
      GSYNC();
    }
    ph_norm(p, l, 1, Mrows, B_xn);
    GSYNC();
    gemm_phase(B_xn, 1024, NOJ, 0, B_WT1, 1024, Mrows, 4096, 1024, EpiMlp1{B_uh}, smem);
    GSYNC();
    gemm_phase(B_uh, 4096, NOJ, 0, B_WT2, 4096, Mrows, 1024, 4096, EpiResid{OUTN, (float*)(B_ws + OFF_HCTX), B_mod + (size_t)l * 17 * 6144 + 5120, (const float*)OUTN, (const float*)(B_ws + OFF_HCTX)}, smem);
    GSYNC();
  }
  ph_final_norm(p);
}

extern "C" void kernel_launch(void* const* d_in, const int* in_sizes, int n_in, void* d_out, int out_size,
                              void* d_ws, size_t ws_size, hipStream_t stream) {
  static int grid_blocks = 0;
  if (!grid_blocks) {
    int dev = 0, cus = 0, per_cu = 0;
    (void)hipGetDevice(&dev);
    (void)hipDeviceGetAttribute(&cus, hipDeviceAttributeMultiprocessorCount, dev);
    (void)hipOccupancyMaxActiveBlocksPerMultiprocessor(&per_cu, mega, 256, 0);
    if (per_cu > 2) per_cu = 2;
    if (per_cu < 1) per_cu = 1;
    grid_blocks = cus * per_cu;
  }
  Params p{};
  const float** pp = (const float**)&p;
  for (int i = 0; i < 31; ++i) pp[i] = (const float*)d_in[i];
  p.out = (float*)d_out;
  p.ws = (char*)d_ws;
  (void)hipMemsetAsync((char*)d_ws + OFF_BAR, 0, 16384, stream);
  void* args[] = {&p};
  hipError_t e = hipLaunchCooperativeKernel((void*)mega, dim3(grid_blocks), dim3(256), args, 0, stream);
  if (e != hipSuccess) fprintf(stderr, "cooperative launch failed: %s (grid %d)\n", hipGetErrorString(e), grid_blocks);
}
```

```cpp
#include <hip/hip_runtime.h>
#include <hip/hip_cooperative_groups.h>
#include <cstdio>
#include <cstdint>
namespace cg = cooperative_groups;
#define GSYNC() xcd_barrier(xb)
#define SKIP_EVEN 0
#define EVMASK 127
#define SKIP_ODD 0
#define SKIP_RWKV 0
#define SKIP_MLSTM 0

typedef unsigned short bf16_t;
typedef short bf16x8 __attribute__((ext_vector_type(8)));
typedef float f32x4 __attribute__((ext_vector_type(4)));
typedef float f32x2 __attribute__((ext_vector_type(2)));
typedef unsigned u32x4 __attribute__((ext_vector_type(4)));
typedef unsigned u32x2 __attribute__((ext_vector_type(2)));
#define GL __attribute__((address_space(1)))

constexpr int ML = 32768, MC = 4096, MT = ML + MC;
constexpr size_t SU = 37748736ull;
constexpr size_t OFF_HCTX = 4096;
constexpr size_t OFF_MOD = OFF_HCTX + 16777216ull;
constexpr size_t OFF_ROPEC = OFF_MOD + 1671168ull;
constexpr size_t OFF_ROPES = OFF_ROPEC + 524288ull;
constexpr size_t OFF_GATES = OFF_ROPES + 524288ull;
constexpr size_t OFF_WTIN = OFF_GATES + 2359296ull;
constexpr size_t OFF_WTOUT = OFF_WTIN + 8388608ull;
constexpr size_t OFF_WT1 = OFF_WTOUT + 2097152ull;
constexpr size_t OFF_WT2 = OFF_WT1 + 8388608ull;
constexpr size_t OFF_WUP = OFF_WT2 + 8388608ull;
constexpr size_t OFF_AUP = OFF_WUP + 131072ull;
constexpr size_t OFF_GUP = OFF_AUP + 131072ull;
constexpr size_t OFF_GWT = OFF_GUP + 131072ull;
constexpr size_t OFF_BAR = OFF_GWT + 262144ull;
constexpr size_t OFF_ARENA = 50331648ull;
static_assert(OFF_BAR + 16384ull <= OFF_ARENA, "persistent region overflow");

struct Params {
  const float *x, *c, *ctx, *c_ctx, *ada_w, *ada_b, *mix_out_w, *mlp_w1, *mlp_w2, *ev_in_w, *ml_gate_b, *ml_norm_w,
      *rw_mu, *rw_w0, *rw_w_up, *rw_a0, *rw_a_up, *rw_g_up, *rw_k_k, *rw_k_a, *rw_r_k, *rw_ln_w, *rw_ln_b, *od_in_w,
      *lru_conv_w, *lru_conv_b, *lru_gate_w, *lru_gate_b, *lru_lambda, *na_rpb, *final_norm_w;
  float* out;
  char* ws;
};

__device__ __forceinline__ float bf2f(unsigned h) { return __uint_as_float(h << 16); }
__device__ __forceinline__ float bflo(unsigned u) { return __uint_as_float(u << 16); }
__device__ __forceinline__ float bfhi(unsigned u) { return __uint_as_float(u & 0xffff0000u); }
typedef __bf16 bf16x2_t __attribute__((ext_vector_type(2)));
__device__ __forceinline__ unsigned pk2(float lo, float hi) {
  f32x2 v = {lo, hi};
  bf16x2_t b = __builtin_convertvector(v, bf16x2_t);
  return __builtin_bit_cast(unsigned, b);
}
__device__ __forceinline__ bf16_t f2bf(float f) { return (bf16_t)(pk2(f, 0.f) & 0xffffu); }
__device__ __forceinline__ u32x2 pk4(f32x4 v) { u32x2 r; r.x = pk2(v[0], v[1]); r.y = pk2(v[2], v[3]); return r; }
__device__ __forceinline__ void unpack8(u32x4 u, float* f) {
  f[0] = bflo(u.x); f[1] = bfhi(u.x); f[2] = bflo(u.y); f[3] = bfhi(u.y);
  f[4] = bflo(u.z); f[5] = bfhi(u.z); f[6] = bflo(u.w); f[7] = bfhi(u.w);
}
__device__ __forceinline__ u32x4 pack8(const float* f) {
  u32x4 r; r.x = pk2(f[0], f[1]); r.y = pk2(f[2], f[3]); r.z = pk2(f[4], f[5]); r.w = pk2(f[6], f[7]); return r;
}
__device__ __forceinline__ float sigm(float x) { return 1.f / (1.f + __expf(-x)); }
__device__ __forceinline__ f32x4 mfma16(bf16x8 a, bf16x8 b, f32x4 c) { return __builtin_amdgcn_mfma_f32_16x16x32_bf16(a, b, c, 0, 0, 0); }
template <class T> __device__ __forceinline__ T* opq_(T* p) {
  unsigned lo = __builtin_amdgcn_readfirstlane((unsigned)(uintptr_t)p);
  unsigned hi = __builtin_amdgcn_readfirstlane((unsigned)((uintptr_t)p >> 32));
  asm volatile("" : "+s"(lo), "+s"(hi));
  return (T*)(((uintptr_t)hi << 32) | (uintptr_t)lo);
}
#define OPQ(x) x = opq_(x)
__device__ __forceinline__ int tid_() { int t = threadIdx.x; asm volatile("" : "+v"(t)); return t; }
__device__ __forceinline__ int gdim_() { int t = gridDim.x; asm volatile("" : "+s"(t)); return t; }
__device__ __forceinline__ int bid_() { int t = blockIdx.x; asm volatile("" : "+s"(t)); return t; }
__device__ __forceinline__ float* hrow2(float* out, float* hctx, int row) {
  return row < ML ? out + (size_t)row * 1024 : hctx + (size_t)(row - ML) * 1024;
}
__device__ __forceinline__ int mrow_of(int row) { return row < ML ? (row >> 11) : 16; }
template <int CTRL> __device__ __forceinline__ float dppf(float x) {
  return __int_as_float(__builtin_amdgcn_update_dpp(0, __float_as_int(x), CTRL, 0xF, 0xF, true));
}
__device__ __forceinline__ float red8(float x) {
  x += dppf<0xB1>(x); x += dppf<0x4E>(x); x += dppf<0x141>(x); return x;
}
__device__ __forceinline__ float wave_sum(float v) {
#pragma unroll
  for (int o = 32; o > 0; o >>= 1) v += __shfl_xor(v, o);
  return v;
}

__device__ __forceinline__ void convT_tile(const float* src, int N, int k0, int n0, bf16_t* dst, int ldd, float* tile) {
  const int tidq = tid_(); const int gdq = gdim_(); const int bidq = bid_(); (void)gdq; (void)bidq;
  OPQ(src); OPQ(dst);
  const int t = tidq, c4 = (t & 15) * 4, r = t >> 4;
#pragma unroll
  for (int i = 0; i < 4; ++i) {
    const int k = r + 16 * i;
    f32x4 v = {0.f, 0.f, 0.f, 0.f};
    if (n0 + c4 < N) v = *(const GL f32x4*)(src + (size_t)(k0 + k) * N + n0 + c4);
    tile[k * 65 + c4 + 0] = v[0]; tile[k * 65 + c4 + 1] = v[1]; tile[k * 65 + c4 + 2] = v[2]; tile[k * 65 + c4 + 3] = v[3];
  }
  __syncthreads();
  const int n = t >> 2, kq = (t & 3) * 16;
  float f[16];
#pragma unroll
  for (int j = 0; j < 16; ++j) f[j] = tile[(kq + j) * 65 + n];
  bf16_t* d = dst + (size_t)(n0 + n) * ldd + k0 + kq;
  *(GL u32x4*)d = pack8(f);
  *(GL u32x4*)(d + 8) = pack8(f + 8);
  __syncthreads();
}
__device__ __forceinline__ void conv_matrix(const float* src, int K, int N, int Npad, bf16_t* dst, int ldd, float* tile) {
  const int tidq = tid_(); const int gdq = gdim_(); const int bidq = bid_(); (void)gdq; (void)bidq;
  const int ntk = K / 64, ntn = Npad / 64;
  for (int t = bidq; t < ntk * ntn; t += gdq) convT_tile(src, N, (t % ntk) * 64, (t / ntk) * 64, dst, ldd, tile);
}
__device__ __forceinline__ void ph_convert(const Params& p, int l, char* smem) {
  const int tidq = tid_(); const int gdq = gdim_(); const int bidq = bid_(); (void)gdq; (void)bidq;
  float* tile = (float*)smem;
  char* ws = p.ws;
  if ((l & 1) == 0) {
    const int e = l >> 1;
    conv_matrix(p.ev_in_w + (size_t)e * 1024 * 3984, 1024, 3984, 4096, (bf16_t*)(ws + OFF_WTIN), 1024, tile);
    for (int d = 0; d < 2; ++d) {
      conv_matrix(p.rw_w_up + (size_t)(e * 2 + d) * 64 * 512, 64, 512, 512, (bf16_t*)(ws + OFF_WUP) + d * 512 * 64, 64, tile);
      conv_matrix(p.rw_a_up + (size_t)(e * 2 + d) * 64 * 512, 64, 512, 512, (bf16_t*)(ws + OFF_AUP) + d * 512 * 64, 64, tile);
    }
    conv_matrix(p.rw_g_up + (size_t)e * 128 * 512, 128, 512, 512, (bf16_t*)(ws + OFF_GUP), 128, tile);
  } else {
    const int o = l >> 1;
    conv_matrix(p.od_in_w + (size_t)o * 1024 * 2560, 1024, 2560, 2560, (bf16_t*)(ws + OFF_WTIN), 1024, tile);
    for (int t = bidq; t < 32; t += gdq) {
      const int zg = t >> 3, n = t & 7;
      convT_tile(p.lru_gate_w + (size_t)(((o * 4 + zg) * 8 + n)) * 4096, 64, 0, 0, (bf16_t*)(ws + OFF_GWT) + (size_t)n * 256 * 64 + zg * 64 * 64, 64, tile);
    }
  }
  conv_matrix(p.mix_out_w + (size_t)l * 1024 * 1024, 1024, 1024, 1024, (bf16_t*)(ws + OFF_WTOUT), 1024, tile);
  conv_matrix(p.mlp_w1 + (size_t)l * 1024 * 4096, 1024, 4096, 4096, (bf16_t*)(ws + OFF_WT1), 1024, tile);
  conv_matrix(p.mlp_w2 + (size_t)l * 4096 * 1024, 4096, 1024, 1024, (bf16_t*)(ws + OFF_WT2), 4096, tile);
}

__device__ __forceinline__ void ph_prologue(const Params& p, char* smem) {
  const int tidq = tid_(); const int gdq = gdim_(); const int bidq = bid_(); (void)gdq; (void)bidq;
  const int gtid = bidq * 256 + tidq, gsz = gdq * 256;
  {
    float* rc = (float*)(p.ws + OFF_ROPEC); float* rs = (float*)(p.ws + OFF_ROPES);
    for (int i = gtid; i < 2048 * 64; i += gsz) {
      const int t = i >> 6, f = i & 63;
      const float pos = (f < 32) ? (float)(t >> 6) : (float)(t & 63);
      const float inv = powf(10000.0f, -(float)(f & 31) / 32.0f);
      const float ang = pos * inv;
      rc[i] = cosf(ang); rs[i] = sinf(ang);
    }
  }
  float* s = (float*)smem;
  float* mod = (float*)(p.ws + OFF_MOD);
  for (int item = bidq; item < 384; item += gdq) {
    const int l = item / 96, n0 = (item % 96) * 64;
    for (int idx = tidq; idx < 17 * 1024; idx += 256) {
      const int r = idx >> 10, k = idx & 1023;
      const float cv = r < 16 ? p.c[r * 1024 + k] : p.c_ctx[k];
      s[idx] = cv / (1.f + expf(-cv));
    }
    __syncthreads();
    const int kq = tidq >> 6, nn = tidq & 63;
    float acc[17];
#pragma unroll
    for (int r = 0; r < 17; ++r) acc[r] = 0.f;
    const float* wp = p.ada_w + ((size_t)l * 1024 + kq * 256) * 6144 + n0 + nn;
    for (int k = 0; k < 256; k += 4) {
      const float w0 = wp[(size_t)(k + 0) * 6144], w1 = wp[(size_t)(k + 1) * 6144], w2 = wp[(size_t)(k + 2) * 6144], w3 = wp[(size_t)(k + 3) * 6144];
#pragma unroll
      for (int r = 0; r < 17; ++r) {
        const f32x4 sv = *(const f32x4*)(s + r * 1024 + kq * 256 + k);
        acc[r] += sv[0] * w0 + sv[1] * w1 + sv[2] * w2 + sv[3] * w3;
      }
    }
    __syncthreads();
#pragma unroll
    for (int r = 0; r < 17; ++r) s[(kq * 17 + r) * 64 + nn] = acc[r];
    __syncthreads();
    for (int idx = tidq; idx < 17 * 64; idx += 256) {
      const int r = idx >> 6, n = idx & 63;
      float v = p.ada_b[l * 6144 + n0 + n];
#pragma unroll
      for (int q = 0; q < 4; ++q) v += s[(q * 17 + r) * 64 + n];
      mod[((size_t)l * 17 + r) * 6144 + n0 + n] = v;
    }
    __syncthreads();
  }
}

__device__ __forceinline__ void ph_norm(const Params& p, int l, int which, int Mrows, bf16_t* xn, bool from_input = false) {
  const int tidq = tid_(); const int gdq = gdim_(); const int bidq = bid_(); (void)gdq; (void)bidq;
  const int lane = tidq & 63;
  float* out_ = from_input ? (float*)p.x : p.out; char* ws_ = p.ws; OPQ(out_); OPQ(ws_); OPQ(xn);
  float* hctx_ = from_input ? (float*)p.ctx : (float*)(ws_ + OFF_HCTX); OPQ(hctx_);
  const float* mod = (const float*)(ws_ + OFF_MOD) + (size_t)l * 17 * 6144 + which * 3072;
  constexpr int R = 4;
  const int nw = gdq * 4;
  for (int row0 = bidq * 4 + (tidq >> 6); row0 < Mrows; row0 += nw * R) {
    f32x4 v[R][4];
#pragma unroll
    for (int j = 0; j < R; ++j) {
      const int row = row0 + j * nw;
      if (row < Mrows) {
        const float* h = hrow2(out_, hctx_, row);
#pragma unroll
        for (int i = 0; i < 4; ++i) v[j][i] = *(const GL f32x4*)(h + i * 256 + lane * 4);
      }
    }
#pragma unroll
    for (int j = 0; j < R; ++j) {
      const int row = row0 + j * nw;
      if (row < Mrows) {
        float ss = 0.f;
#pragma unroll
        for (int i = 0; i < 4; ++i) ss += v[j][i][0] * v[j][i][0] + v[j][i][1] * v[j][i][1] + v[j][i][2] * v[j][i][2] + v[j][i][3] * v[j][i][3];
        ss = wave_sum(ss);
        const float rstd = rsqrtf(ss * (1.f / 1024.f) + 1e-6f);
        const float* m = mod + (size_t)mrow_of(row) * 6144;
#pragma unroll
        for (int i = 0; i < 4; ++i) {
          const int col = i * 256 + lane * 4;
          const f32x4 sh = *(const GL f32x4*)(m + col), sc = *(const GL f32x4*)(m + 1024 + col);
          f32x4 o = v[j][i] * rstd * (sc + 1.f) + sh;
          *(GL u32x2*)(xn + (size_t)row * 1024 + col) = pk4(o);
        }
      }
    }
  }
}
__device__ __forceinline__ void ph_final_norm(const Params& p) {
  const int tidq = tid_(); const int gdq = gdim_(); const int bidq = bid_(); (void)gdq; (void)bidq;
  const int lane = tidq & 63;
  float* out_ = p.out; OPQ(out_);
  constexpr int R = 4;
  const int nw = gdq * 4;
  for (int row0 = bidq * 4 + (tidq >> 6); row0 < ML; row0 += nw * R) {
    f32x4 v[R][4];
#pragma unroll
    for (int j = 0; j < R; ++j) {
      const int row = row0 + j * nw;
      if (row < ML) {
#pragma unroll
        for (int i = 0; i < 4; ++i) v[j][i] = *(const GL f32x4*)(out_ + (size_t)row * 1024 + i * 256 + lane * 4);
      }
    }
#pragma unroll
    for (int j = 0; j < R; ++j) {
      const int row = row0 + j * nw;
      if (row < ML) {
        float ss = 0.f;
#pragma unroll
        for (int i = 0; i < 4; ++i) ss += v[j][i][0] * v[j][i][0] + v[j][i][1] * v[j][i][1] + v[j][i][2] * v[j][i][2] + v[j][i][3] * v[j][i][3];
        ss = wave_sum(ss);
        const float rstd = rsqrtf(ss * (1.f / 1024.f) + 1e-6f);
#pragma unroll
        for (int i = 0; i < 4; ++i) {
          const int col = i * 256 + lane * 4;
          const f32x4 w = *(const GL f32x4*)(p.final_norm_w + col);
          *(GL f32x4*)(out_ + (size_t)row * 1024 + col) = v[j][i] * rstd * w;
        }
      }
    }
  }
}

template <int MI, class Epi>
__device__ __forceinline__ void gemm_phase_t(const bf16_t* A, int lda, int jump_at, int jump, const bf16_t* Bt, int ldb,
                           int Mrows, int N, int K, Epi epi, char* smem, int a_grp = 0) {
  const int tidq = tid_(); const int gdq = gdim_(); const int bidq = bid_();
  OPQ(A); OPQ(Bt); epi.launder();
  const int tid = tidq, lane = tid & 63, w = tid >> 6, wr = w >> 1, wc = w & 1, fr = lane & 15, fq = lane >> 4;
  constexpr int BM = MI * 32;
  const int ntm = Mrows / BM, ntn = (N + 127) / 128, nk = K / 64;
  char* As = smem;
  char* Bs = As + BM * 128;
  const int lrow = tid >> 3, lc = (tid & 7) * 8;
  const int lsw = ((tid & 7) ^ ((lrow >> 1) & 7)) << 4;
  const int rsw = (fr >> 1) & 7;
  const int xcd = bidq & 7, slot = bidq >> 3, nslot = gdq >> 3;
  const bool xmap = ((ntm & 7) == 0) && ((gdq & 7) == 0);
  const int ntml = ntm >> 3;
  const int tper = xmap ? ntml * ntn : ntm * ntn;
  const int tj0 = xmap ? slot : bidq, tjs = xmap ? nslot : gdq;
  const int BW = (ntn >= 16) ? 4 : 8;
#define TILE_OF(TJ, M0, N0) { int tm_, tn_; \
    if (xmap) { const int band_ = (TJ) / (BW * ntn), rem_ = (TJ) - band_ * BW * ntn; const int rib_ = min(BW, ntml - band_ * BW); \
      tn_ = rem_ / rib_; tm_ = (band_ * BW + (rem_ - tn_ * rib_)) * 8 + xcd; } \
    else { tm_ = (TJ) / ntn; tn_ = (TJ) % ntn; } \
    M0 = tm_ * BM; N0 = tn_ * 128; }
  u32x4 ra[MI], rb[4];
#define GLOAD(AP, BP, KT) { const int k0_ = (KT) * 64 + lc, ka_ = k0_ + (k0_ >= jump_at ? jump : 0); \
      _Pragma("unroll") for (int i = 0; i < MI; ++i) ra[i] = *(const GL u32x4*)((AP) + (size_t)(32 * i) * lda + ka_); \
      _Pragma("unroll") for (int i = 0; i < 4; ++i) rb[i] = *(const GL u32x4*)((BP) + (size_t)(32 * i) * ldb + k0_); }
  if (tj0 < tper) {
    int m0, n0; TILE_OF(tj0, m0, n0);
    GLOAD(A + (size_t)(m0 + lrow) * lda + (a_grp ? (n0 / a_grp) * K : 0), Bt + (size_t)(n0 + lrow) * ldb, 0);
  }
  for (int tj = tj0; tj < tper; tj += tjs) {
    int m0, n0; TILE_OF(tj, m0, n0);
    int m1 = m0, n1 = n0;
    const bool has_next = (tj + tjs) < tper;
    if (has_next) TILE_OF(tj + tjs, m1, n1);
    f32x4 acc[MI][4];
#pragma unroll
    for (int i = 0; i < MI; ++i)
#pragma unroll
      for (int j = 0; j < 4; ++j) acc[i][j] = (f32x4){0.f, 0.f, 0.f, 0.f};
    const bf16_t* Ap = A + (size_t)(m0 + lrow) * lda + (a_grp ? (n0 / a_grp) * K : 0);
    const bf16_t* Bp = Bt + (size_t)(n0 + lrow) * ldb;
    const bf16_t* Ap1 = A + (size_t)(m1 + lrow) * lda + (a_grp ? (n1 / a_grp) * K : 0);
    const bf16_t* Bp1 = Bt + (size_t)(n1 + lrow) * ldb;
    if constexpr (MI > 6) { if (tj != tj0) GLOAD(Ap, Bp, 0); }
    for (int kt = 0; kt < nk; ++kt) {
      __syncthreads();
#pragma unroll
      for (int i = 0; i < MI; ++i) *(u32x4*)(As + (lrow + 32 * i) * 128 + lsw) = ra[i];
#pragma unroll
      for (int i = 0; i < 4; ++i) *(u32x4*)(Bs + (lrow + 32 * i) * 128 + lsw) = rb[i];
      __syncthreads();
      {
        if constexpr (MI <= 6) {
          const bool lastk = (kt + 1 == nk);
          const bf16_t* ap_ = lastk ? Ap1 : Ap;
          const bf16_t* bp_ = lastk ? Bp1 : Bp;
          const int kn_ = lastk ? 0 : kt + 1;
          GLOAD(ap_, bp_, kn_);
        } else {
          GLOAD(Ap, Bp, min(kt + 1, nk - 1));
        }
      }
#pragma unroll
      for (int ks = 0; ks < 2; ++ks) {
        bf16x8 bfr[4];
#pragma unroll
        for (int ni = 0; ni < 4; ++ni) bfr[ni] = *(const bf16x8*)(Bs + (wc * 64 + ni * 16 + fr) * 128 + (((ks * 4 + fq) ^ rsw) << 4));
#pragma unroll
        for (int mi = 0; mi < MI; ++mi) {
          const bf16x8 af = *(const bf16x8*)(As + (wr * (BM / 2) + mi * 16 + fr) * 128 + (((ks * 4 + fq) ^ rsw) << 4));
#pragma unroll
          for (int ni = 0; ni < 4; ++ni) acc[mi][ni] = mfma16(bfr[ni], af, acc[mi][ni]);
        }
      }
    }
#pragma unroll
    for (int mi = 0; mi < MI; ++mi)
#pragma unroll
      for (int ni = 0; ni < 4; ++ni) {
        const int row = m0 + wr * (BM / 2) + mi * 16 + fr, col = n0 + wc * 64 + ni * 16 + fq * 4;
        if (col < N) epi(row, col, acc[mi][ni]);
      }
  }
#undef GLOAD
#undef TILE_OF
}

template <class Epi>
__device__ __forceinline__ void gemm_phase(const bf16_t* A, int lda, int jump_at, int jump, const bf16_t* Bt, int ldb,
                           int Mrows, int N, int K, Epi epi, char* smem) {
  if (N <= 512) gemm_phase_t<4>(A, lda, jump_at, jump, Bt, ldb, Mrows, N, K, epi, smem);
  else if (N == 1024 && Mrows == MT) gemm_phase_t<6>(A, lda, jump_at, jump, Bt, ldb, Mrows, N, K, epi, smem);
  else gemm_phase_t<8>(A, lda, jump_at, jump, Bt, ldb, Mrows, N, K, epi, smem);
}

struct EpiInEven {
  bf16_t* zm; bf16_t* zw; float* gates;
  __device__ __forceinline__ void launder() { OPQ(zm); OPQ(zw); OPQ(gates); }
  __device__ __forceinline__ void operator()(int row, int col, f32x4 v) const {
    if (col < 2048) *(GL u32x2*)(zm + (size_t)row * 2048 + col) = pk4(v);
    else if (col < 2064) *(GL f32x4*)(gates + (size_t)row * 16 + (col - 2048)) = v;
    else *(GL u32x2*)(zw + (size_t)row * 1920 + (col - 2064)) = pk4(v);
  }
};
struct EpiStore {
  bf16_t* o; int ld;
  __device__ __forceinline__ void launder() { OPQ(o); }
  __device__ __forceinline__ void operator()(int row, int col, f32x4 v) const { *(GL u32x2*)(o + (size_t)row * ld + col) = pk4(v); }
};
struct EpiResid {
  float* out; float* hctx; const float* gate; const float* srcl; const float* srcc;
  __device__ __forceinline__ void launder() { OPQ(out); OPQ(hctx); OPQ(gate); OPQ(srcl); OPQ(srcc); }
  __device__ __forceinline__ void operator()(int row, int col, f32x4 v) const {
    float* h = hrow2(out, hctx, row) + col;
    const float* hs = (row < ML ? srcl + (size_t)row * 1024 : srcc + (size_t)(row - ML) * 1024) + col;
    const f32x4 g = *(const GL f32x4*)(gate + (size_t)mrow_of(row) * 6144 + col);
    f32x4 hv = *(const GL f32x4*)hs;
    hv += g * v;
    *(GL f32x4*)h = hv;
  }
};
struct EpiMlp1 {
  bf16_t* u;
  __device__ __forceinline__ void launder() { OPQ(u); }
  __device__ __forceinline__ void operator()(int row, int col, f32x4 v) const {
    f32x4 r;
#pragma unroll
    for (int i = 0; i < 4; ++i) { const float t = fmaxf(v[i], 0.f); r[i] = t * t; }
    *(GL u32x2*)(u + (size_t)row * 4096 + col) = pk4(r);
  }
};
struct EpiLd {
  _Float16* ld; const float* w0;
  __device__ __forceinline__ void launder() { OPQ(ld); OPQ(w0); }
  __device__ __forceinline__ void operator()(int row, int col, f32x4 v) const {
    const f32x4 b = *(const GL f32x4*)(w0 + col);
    _Float16 o[4];
#pragma unroll
    for (int i = 0; i < 4; ++i) o[i] = (_Float16)(-0.60653065971f * sigm(v[i] + b[i]));
    *(GL u32x2*)(ld + (size_t)row * 512 + col) = *(const u32x2*)o;
  }
};
struct EpiAlr {
  bf16_t* alr; const float* a0;
  __device__ __forceinline__ void launder() { OPQ(alr); OPQ(a0); }
  __device__ __forceinline__ void operator()(int row, int col, f32x4 v) const {
    const f32x4 b = *(const GL f32x4*)(a0 + col);
    f32x4 r;
#pragma unroll
    for (int i = 0; i < 4; ++i) r[i] = sigm(v[i] + b[i]);
    *(GL u32x2*)(alr + (size_t)row * 512 + col) = pk4(r);
  }
};
struct EpiLdV {
  _Float16* ld; const float* w0;
  __device__ __forceinline__ void launder() { OPQ(ld); OPQ(w0); }
  __device__ __forceinline__ void operator()(int row, int colv, f32x4 v) const {
    const int g = colv >> 9, col = colv & 511;
    const f32x4 b = *(const GL f32x4*)(w0 + colv);
    _Float16 o[4];
#pragma unroll
    for (int i = 0; i < 4; ++i) o[i] = (_Float16)(-0.60653065971f * sigm(v[i] + b[i]));
    *(GL u32x2*)(ld + ((size_t)g * MT + row) * 512 + col) = *(const u32x2*)o;
  }
};
struct EpiGates {
  bf16_t* g; const float* gb;
  __device__ __forceinline__ void launder() { OPQ(g); OPQ(gb); }
  __device__ __forceinline__ void operator()(int row, int colv, f32x4 v) const {
    const int n = colv >> 8, cl = colv & 255;
    const int zg = cl >> 6, d = cl & 63, c = zg * 512 + n * 64 + d;
    const f32x4 b = *(const GL f32x4*)(gb + c);
    f32x4 r;
#pragma unroll
    for (int i = 0; i < 4; ++i) r[i] = sigm(v[i] + b[i]);
    *(GL u32x2*)(g + (size_t)row * 2048 + c) = pk4(r);
  }
};

__device__ __forceinline__ void ph_rope(const Params& p, bf16_t* zm) {
  const int tidq = tid_(); const int gdq = gdim_(); const int bidq = bid_(); (void)gdq; (void)bidq;
  OPQ(zm);
  const int lane = tidq & 63;
  const int part = lane >> 5, head = (lane >> 3) & 3, d = (lane & 7) * 8;
  char* ws_ = p.ws; OPQ(ws_);
  const float* rc = (const float*)(ws_ + OFF_ROPEC); const float* rs = (const float*)(ws_ + OFF_ROPES);
  const float sc = part ? 0.08838834764831845f : 1.f;
  constexpr int R = 4;
  const int nw = gdq * 4;
  for (int row0 = bidq * 4 + (tidq >> 6); row0 < MT; row0 += nw * R) {
    u32x4 a[R], b[R];
    f32x4 c0[R], c1[R], s0[R], s1[R];
#pragma unroll
    for (int j = 0; j < R; ++j) {
      const int row = row0 + j * nw;
      if (row < MT) {
        bf16_t* base = zm + (size_t)row * 2048 + part * 512 + head * 128;
        a[j] = *(const GL u32x4*)(base + d); b[j] = *(const GL u32x4*)(base + 64 + d);
        if (row < ML) {
          const int t = row & 2047;
          c0[j] = *(const GL f32x4*)(rc + t * 64 + d); c1[j] = *(const GL f32x4*)(rc + t * 64 + d + 4);
          s0[j] = *(const GL f32x4*)(rs + t * 64 + d); s1[j] = *(const GL f32x4*)(rs + t * 64 + d + 4);
        }
      }
    }
#pragma unroll
    for (int j = 0; j < R; ++j) {
      const int row = row0 + j * nw;
      if (row < MT) {
        bf16_t* base = zm + (size_t)row * 2048 + part * 512 + head * 128;
        float x1[8], x2[8], o1[8], o2[8];
        unpack8(a[j], x1); unpack8(b[j], x2);
        if (row < ML) {
#pragma unroll
          for (int i = 0; i < 8; ++i) {
            const float c = i < 4 ? c0[j][i & 3] : c1[j][i & 3], s = i < 4 ? s0[j][i & 3] : s1[j][i & 3];
            o1[i] = (x1[i] * c - x2[i] * s) * sc; o2[i] = (x1[i] * s + x2[i] * c) * sc;
          }
        } else {
#pragma unroll
          for (int i = 0; i < 8; ++i) { o1[i] = x1[i] * sc; o2[i] = x2[i] * sc; }
        }
        if (row < ML || part) { *(GL u32x4*)(base + d) = pack8(o1); *(GL u32x4*)(base + 64 + d) = pack8(o2); }
      }
    }
  }
}

__device__ __forceinline__ void mlstm_item(const Params& p, int e, int item, const bf16_t* zm, const float* gates, bf16_t* hm, char* smem) {
  const int tidq = tid_(); const int gdq = gdim_(); const int bidq = bid_(); (void)gdq; (void)bidq;
  OPQ(zm); OPQ(gates); OPQ(hm);
  const int eh = item & 1, hh = (item >> 1) & 3, b = (item >> 3) & 15, dir = item >> 7;
  const int tid = tidq, lane = tid & 63, w = tid >> 6, fr = lane & 15, fq = lane >> 4;
  bf16_t* Vt = (bf16_t*)smem;
  bf16_t* Kt = (bf16_t*)(smem + 11520);
  bf16_t* Kn = (bf16_t*)(smem + 11520);
  bf16_t* Ct = (bf16_t*)(smem + 29952);
  bf16_t* Ps = (bf16_t*)(smem + 51712);
  float* fu = (float*)(smem + 60928);
  float* fM = fu + 64;
  float* fb = fu + 128;
  for (int i = tid; i < 80 * 136 / 2; i += 256) ((unsigned*)Ct)[i] = 0u;
  for (int i = tid; i < 16 * 72; i += 256) Vt[64 * 72 + i] = (i < 72) ? (bf16_t)0x3F80 : (bf16_t)0;
  f32x4 acc[2][5];
#pragma unroll
  for (int i = 0; i < 2; ++i)
#pragma unroll
    for (int j = 0; j < 5; ++j) acc[i][j] = (f32x4){0.f, 0.f, 0.f, 0.f};
  float m = 0.f;
  const float gbi = p.ml_gate_b[e * 16 + dir * 8 + hh], gbf = p.ml_gate_b[e * 16 + dir * 8 + 4 + hh];
  const int tq = 16 * w + fr;
  int rbase = 0, rstep = 1;
  auto setrow = [&](int c) {
    const bool isctx = c < 4;
    const int cc = isctx ? c : c - 4, len = isctx ? 256 : 2048, base = isctx ? ML + b * 256 : b * 2048;
    rbase = dir ? base + len - 1 - cc * 64 : base + cc * 64;
    rstep = dir ? -1 : 1;
  };
#define MROW(pp) (rbase + rstep * (pp))
  u32x4 vv[2], kv[4];
  bf16x8 qfn[4];
  float gli = 0.f, gfr = 0.f;
  auto prefetch = [&](int c) {
    setrow(c);
#pragma unroll
    for (int i = 0; i < 2; ++i) { const int s = lane, e8 = (w * 2 + i) * 8; vv[i] = *(const GL u32x4*)(zm + (size_t)MROW(s) * 2048 + 1024 + hh * 128 + eh * 64 + e8); }
#pragma unroll
    for (int i = 0; i < 4; ++i) { const int s = lane, d8 = (w * 4 + i) * 8; kv[i] = *(const GL u32x4*)(zm + (size_t)MROW(s) * 2048 + 512 + hh * 128 + d8); }
#pragma unroll
    for (int ks = 0; ks < 4; ++ks) qfn[ks] = *(const GL bf16x8*)(zm + (size_t)MROW(tq) * 2048 + hh * 128 + ks * 32 + fq * 8);
    if (w == 0) { const float* g = gates + (size_t)MROW(lane) * 16; gli = g[dir * 4 + hh]; gfr = g[8 + dir * 4 + hh]; }
  };
  prefetch(0);
  __syncthreads();
  for (int c = 0; c < 36; ++c) {
    setrow(c);
    if (w == 0) {
      const float li = gli + gbi;
      const float fraw = gfr + gbf;
      const float lf = fminf(fraw, 0.f) - log1pf(expf(-fabsf(fraw)));
      float bc = lf;
#pragma unroll
      for (int o = 1; o < 64; o <<= 1) { const float t = __shfl_up(bc, o); if (lane >= o) bc += t; }
      const float u = li - bc;
      float pm = u;
#pragma unroll
      for (int o = 1; o < 64; o <<= 1) { const float t = __shfl_up(pm, o); if (lane >= o) pm = fmaxf(pm, t); }
      fu[lane] = u; fM[lane] = fmaxf(m, pm); fb[lane] = bc;
    }
#pragma unroll
    for (int i = 0; i < 2; ++i) {
      const int s = lane, e8 = (w * 2 + i) * 8;
      const unsigned uu[4] = {vv[i].x, vv[i].y, vv[i].z, vv[i].w};
#pragma unroll
      for (int j = 0; j < 4; ++j) { Vt[(e8 + 2 * j) * 72 + s] = (bf16_t)(uu[j] & 0xffffu); Vt[(e8 + 2 * j + 1) * 72 + s] = (bf16_t)(uu[j] >> 16); }
    }
#pragma unroll
    for (int i = 0; i < 4; ++i) { const int s = lane, d8 = (w * 4 + i) * 8; *(u32x4*)(Kn + s * 136 + d8) = kv[i]; }
    bf16x8 qf[4];
#pragma unroll
    for (int ks = 0; ks < 4; ++ks) qf[ks] = qfn[ks];
    __syncthreads();
    const float M63 = fM[63];
    const float Mt = fM[tq];
#pragma unroll
    for (int ni = 0; ni < 4; ++ni) {
      f32x4 sa = {0.f, 0.f, 0.f, 0.f};
#pragma unroll
      for (int ks = 0; ks < 4; ++ks) {
        const bf16x8 kfr = *(const bf16x8*)(Kn + (ni * 16 + fr) * 136 + ks * 32 + fq * 8);
        sa = mfma16(kfr, qf[ks], sa);
      }
      const int s0 = ni * 16 + fq * 4;
      const f32x4 u4 = *(const f32x4*)(fu + s0);
      f32x4 pv;
#pragma unroll
      for (int j = 0; j < 4; ++j) pv[j] = (s0 + j <= tq) ? sa[j] * __expf(u4[j] - Mt) : 0.f;
      *(u32x2*)(Ps + tq * 72 + s0) = pk4(pv);
    }
    __syncthreads();
#pragma unroll
    for (int i = 0; i < 4; ++i) {
      const int s = lane, d8 = (w * 4 + i) * 8;
      const float wk = __expf(fu[s] - M63);
      float kf[8];
      unpack8(kv[i], kf);
#pragma unroll
      for (int j = 0; j < 8; ++j) Kt[(d8 + j) * 72 + s] = f2bf(kf[j] * wk);
    }
    const int orow = MROW(tq);
    if (c + 1 < 36) prefetch(c + 1);
    f32x4 aC[5], aP[5];
#pragma unroll
    for (int ni = 0; ni < 5; ++ni) { aC[ni] = (f32x4){0.f, 0.f, 0.f, 0.f}; aP[ni] = (f32x4){0.f, 0.f, 0.f, 0.f}; }
#pragma unroll
    for (int ni = 0; ni < 5; ++ni)
#pragma unroll
      for (int ks = 0; ks < 4; ++ks) {
        const bf16x8 cf = *(const bf16x8*)(Ct + (ni * 16 + fr) * 136 + ks * 32 + fq * 8);
        aC[ni] = mfma16(cf, qf[ks], aC[ni]);
      }
#pragma unroll
    for (int ks = 0; ks < 2; ++ks) {
      const bf16x8 pf = *(const bf16x8*)(Ps + tq * 72 + ks * 32 + fq * 8);
#pragma unroll
      for (int ni = 0; ni < 5; ++ni) {
        const bf16x8 vf = *(const bf16x8*)(Vt + (ni * 16 + fr) * 72 + ks * 32 + fq * 8);
        aP[ni] = mfma16(vf, pf, aP[ni]);
      }
    }
    {
      const float wprev = __expf(m - Mt);
      const float dval = wprev * aC[4][0] + aP[4][0];
      const float den = __shfl(dval, fr);
      const float dn = fmaxf(fabsf(den), __expf(-(fb[tq] + Mt)));
      const float inv = 1.f / dn;
      bf16_t* ho = hm + ((size_t)dir * MT + orow) * 512 + hh * 128 + eh * 64 + fq * 4;
#pragma unroll
      for (int ni = 0; ni < 4; ++ni) {
        const f32x4 hv = (aC[ni] * wprev + aP[ni]) * inv;
        *(GL u32x2*)(ho + ni * 16) = pk4(hv);
      }
    }
    const float bend = fb[63];
    __syncthreads();
    const float keep = __expf(m - M63);
#pragma unroll
    for (int mi = 0; mi < 2; ++mi)
#pragma unroll
      for (int ni = 0; ni < 5; ++ni) acc[mi][ni] *= keep;
#pragma unroll
    for (int ks = 0; ks < 2; ++ks) {
      bf16x8 vf[5];
#pragma unroll
      for (int ni = 0; ni < 5; ++ni) vf[ni] = *(const bf16x8*)(Vt + (ni * 16 + fr) * 72 + ks * 32 + fq * 8);
#pragma unroll
      for (int mi = 0; mi < 2; ++mi) {
        const bf16x8 kf = *(const bf16x8*)(Kt + (32 * w + mi * 16 + fr) * 72 + ks * 32 + fq * 8);
#pragma unroll
        for (int ni = 0; ni < 5; ++ni) acc[mi][ni] = mfma16(kf, vf[ni], acc[mi][ni]);
      }
    }
#pragma unroll
    for (int mi = 0; mi < 2; ++mi)
#pragma unroll
      for (int ni = 0; ni < 5; ++ni) *(u32x2*)(Ct + (ni * 16 + fr) * 136 + 32 * w + mi * 16 + fq * 4) = pk4(acc[mi][ni]);
    m = bend + M63;
    __syncthreads();
  }
#undef MROW
}

__device__ __forceinline__ void ph_mlstm_post(const Params& p, int e, const bf16_t* zm, const bf16_t* hm, bf16_t* mix) {
  const int tidq = tid_(); const int gdq = gdim_(); const int bidq = bid_(); (void)gdq; (void)bidq;
  OPQ(zm); OPQ(hm); OPQ(mix);
  const int lane = tidq & 63, c = lane * 8;
  float nw_[8];
#pragma unroll
  for (int i = 0; i < 8; ++i) nw_[i] = p.ml_norm_w[e * 512 + c + i];
  constexpr int R = 4;
  const int nw = gdq * 4;
  for (int row0 = bidq * 4 + (tidq >> 6); row0 < MT; row0 += nw * R) {
    u32x4 ua[R], ub[R], uo[R];
#pragma unroll
    for (int j = 0; j < R; ++j) {
      const int row = row0 + j * nw;
      if (row < MT) {
        ua[j] = *(const GL u32x4*)(hm + (size_t)row * 512 + c);
        ub[j] = *(const GL u32x4*)(hm + ((size_t)MT + row) * 512 + c);
        uo[j] = *(const GL u32x4*)(zm + (size_t)row * 2048 + 1536 + c);
      }
    }
#pragma unroll
    for (int j = 0; j < R; ++j) {
      const int row = row0 + j * nw;
      if (row < MT) {
        float a[8], b2[8], og[8], o[8];
        unpack8(ua[j], a); unpack8(ub[j], b2); unpack8(uo[j], og);
        float ss = 0.f;
#pragma unroll
        for (int i = 0; i < 8; ++i) { a[i] += b2[i]; ss += a[i] * a[i]; }
        ss += __shfl_xor(ss, 1); ss += __shfl_xor(ss, 2); ss += __shfl_xor(ss, 4); ss += __shfl_xor(ss, 8);
        const float rstd = rsqrtf(ss * (1.f / 128.f) + 1e-6f);
#pragma unroll
        for (int i = 0; i < 8; ++i) o[i] = a[i] * rstd * nw_[i] * sigm(og[i]);
        *(GL u32x4*)(mix + (size_t)row * 1024 + c) = pack8(o);
      }
    }
  }
}

__device__ __forceinline__ void ph_rwkv_prep(const Params& p, int e, const bf16_t* zw, bf16_t* zr, bf16_t* alin) {
  const int tidq = tid_(); const int gdq = gdim_(); const int bidq = bid_(); (void)gdq; (void)bidq;
  OPQ(zw); OPQ(zr); OPQ(alin);
  const int lane = tidq & 63;
  const float* mu = p.rw_mu + e * 1920;
  const int nw = gdq * 4;
  for (int row = bidq * 4 + (tidq >> 6); row < MT; row += nw) {
    int t, len;
    if (row < ML) { t = row & 2047; len = 2048; } else { t = (row - ML) & 255; len = 256; }
    const bool hp = t > 0, hn = t < len - 1;
    u32x4 uz[4], up[4], un[4];
#pragma unroll
    for (int q = 0; q < 4; ++q) {
      const int vi = lane + 64 * q;
      if (vi < 240) {
        const int col = vi * 8;
        uz[q] = *(const GL u32x4*)(zw + (size_t)row * 1920 + col);
        up[q] = (u32x4){0u, 0u, 0u, 0u}; un[q] = (u32x4){0u, 0u, 0u, 0u};
        if (hp) up[q] = *(const GL u32x4*)(zw + (size_t)(row - 1) * 1920 + col);
        if (hn) un[q] = *(const GL u32x4*)(zw + (size_t)(row + 1) * 1920 + col);
      }
    }
#pragma unroll
    for (int q = 0; q < 4; ++q) {
      const int vi = lane + 64 * q;
      if (vi < 240) {
        const int col = vi * 8;
        float z[8], zp[8], zn[8], o[8];
        unpack8(uz[q], z); unpack8(up[q], zp); unpack8(un[q], zn);
        const f32x4 m0 = *(const GL f32x4*)(mu + col), m1 = *(const GL f32x4*)(mu + col + 4);
#pragma unroll
        for (int i = 0; i < 8; ++i) {
          const float mm = i < 4 ? m0[i & 3] : m1[i & 3];
          float v = z[i] + mm * (0.5f * (zp[i] + zn[i]) - z[i]);
          if (col >= 1536 && col < 1664) v = tanhf(v);
          else if (col >= 1792) v = sigm(v);
          o[i] = v;
        }
        if (col < 1536) *(GL u32x4*)(zr + (size_t)row * 1536 + col) = pack8(o);
        else *(GL u32x4*)(alin + (size_t)row * 384 + (col - 1536)) = pack8(o);
      }
    }
  }
}

__device__ __forceinline__ void rwkv_item(const Params& p, int e, int item, const bf16_t* zr, const _Float16* ldp, bf16_t* alr, char* smem) {
  const int tidq = tid_(); const int gdq = gdim_(); const int bidq = bid_(); (void)gdq; (void)bidq;
  OPQ(zr); OPQ(ldp); OPQ(alr);
  const int dir = item >> 7, b = (item >> 3) & 15, hd = item & 7;
  const int tid = tidq;
  float* buf = (float*)smem;
  float* ybuf = (float*)(smem + 49152);
  const int ls = tid >> 4, lc = (tid & 15) * 4;
  const int rp = tid >> 3, sub = tid & 7;
  const f32x4 kk4 = *(const GL f32x4*)(p.rw_k_k + e * 512 + hd * 64 + lc);
  const f32x4 ka4 = *(const GL f32x4*)(p.rw_k_a + e * 512 + hd * 64 + lc);
  const _Float16* ldd = ldp + (size_t)dir * MT * 512;
  bf16_t* ald = alr + (size_t)dir * MT * 512;
  auto rowof = [&](int g) -> int {
    if (g < 256) return ML + b * 256 + (dir ? 255 - g : g);
    const int gl = g - 256;
    return b * 2048 + (dir ? 2047 - gl : gl);
  };
  u32x2 r4, k4, v4, l4, a4;
  auto gload = [&](int c) {
    const int row = rowof(c * 16 + ls);
    const bf16_t* zp = zr + (size_t)row * 1536 + hd * 64 + lc;
    r4 = *(const GL u32x2*)zp; k4 = *(const GL u32x2*)(zp + 512); v4 = *(const GL u32x2*)(zp + 1024);
    l4 = *(const GL u32x2*)(ldd + (size_t)row * 512 + hd * 64 + lc);
    a4 = *(const GL u32x2*)(ald + (size_t)row * 512 + hd * 64 + lc);
  };
  auto stage = [&](int nb) {
    float* d = buf + nb * 6 * 1024 + ls * 64 + lc;
    const f32x4 r = {bflo(r4.x), bfhi(r4.x), bflo(r4.y), bfhi(r4.y)};
    const f32x4 k = {bflo(k4.x), bfhi(k4.x), bflo(k4.y), bfhi(k4.y)};
    const f32x4 v = {bflo(v4.x), bfhi(v4.x), bflo(v4.y), bfhi(v4.y)};
    const f32x4 a = {bflo(a4.x), bfhi(a4.x), bflo(a4.y), bfhi(a4.y)};
    _Float16 lh[4]; *(u32x2*)lh = l4;
    f32x4 kk = k * kk4;
    float ss = kk[0] * kk[0] + kk[1] * kk[1] + kk[2] * kk[2] + kk[3] * kk[3];
    ss += __shfl_xor(ss, 1); ss += __shfl_xor(ss, 2); ss += __shfl_xor(ss, 4); ss += __shfl_xor(ss, 8);
    const float inv = 1.f / fmaxf(sqrtf(ss), 1e-12f);
    kk = kk * inv;
    f32x4 wv, kd, bv;
#pragma unroll
    for (int i = 0; i < 4; ++i) { wv[i] = __expf((float)lh[i]); kd[i] = k[i] * (1.f + (a[i] - 1.f) * ka4[i]); bv[i] = kk[i] * a[i]; }
    *(f32x4*)(d + 0 * 1024) = r; *(f32x4*)(d + 1 * 1024) = wv; *(f32x4*)(d + 2 * 1024) = kd;
    *(f32x4*)(d + 3 * 1024) = v; *(f32x4*)(d + 4 * 1024) = kk; *(f32x4*)(d + 5 * 1024) = bv;
  };
  f32x2 S[8];
#pragma unroll
  for (int j = 0; j < 8; ++j) S[j] = (f32x2){0.f, 0.f};
  __syncthreads();
  gload(0);
  stage(0);
  __syncthreads();
  for (int c = 0; c < 144; ++c) {
    if (c + 1 < 144) gload(c + 1);
    const float* cur = buf + (c & 1) * 6 * 1024;
    float* yb = ybuf + (c & 1) * 1024;
    {
      struct StepIn { f32x4 r0, r1, w0, w1, d0, d1, k0, k1, b0, b1; f32x2 v; };
      auto ldstep = [&](int st) -> StepIn {
        StepIn x;
        const float* q = cur + st * 64 + sub * 8;
        x.k0 = *(const f32x4*)(q + 4096); x.k1 = *(const f32x4*)(q + 4096 + 4);
        x.v = *(const f32x2*)(cur + 3072 + st * 64 + 2 * rp);
        x.d0 = *(const f32x4*)(q + 2048); x.d1 = *(const f32x4*)(q + 2048 + 4);
        x.b0 = *(const f32x4*)(q + 5120); x.b1 = *(const f32x4*)(q + 5120 + 4);
        x.w0 = *(const f32x4*)(q + 1024); x.w1 = *(const f32x4*)(q + 1024 + 4);
        x.r0 = *(const f32x4*)(q); x.r1 = *(const f32x4*)(q + 4);
        return x;
      };
      f32x2 ypend = {0.f, 0.f};
      auto dostep = [&](const StepIn& x, int st) {
        const float rr[8] = {x.r0[0], x.r0[1], x.r0[2], x.r0[3], x.r1[0], x.r1[1], x.r1[2], x.r1[3]};
        const float ww[8] = {x.w0[0], x.w0[1], x.w0[2], x.w0[3], x.w1[0], x.w1[1], x.w1[2], x.w1[3]};
        const float dd[8] = {x.d0[0], x.d0[1], x.d0[2], x.d0[3], x.d1[0], x.d1[1], x.d1[2], x.d1[3]};
        const float kk[8] = {x.k0[0], x.k0[1], x.k0[2], x.k0[3], x.k1[0], x.k1[1], x.k1[2], x.k1[3]};
        const float bb[8] = {x.b0[0], x.b0[1], x.b0[2], x.b0[3], x.b1[0], x.b1[1], x.b1[2], x.b1[3]};
        f32x2 sa0 = S[0] * kk[0], sa1 = S[1] * kk[1];
#pragma unroll
        for (int j = 2; j < 8; j += 2) { sa0 += S[j] * kk[j]; sa1 += S[j + 1] * kk[j + 1]; }
        f32x2 sa = sa0 + sa1;
        if (st > 0) {
          f32x2 yp = ypend;
          yp.x = red8(yp.x); yp.y = red8(yp.y);
          if (sub == 0) *(f32x2*)(yb + (st - 1) * 64 + 2 * rp) = yp;
        }
        sa.x = red8(sa.x); sa.y = red8(sa.y);
        f32x2 y0 = {0.f, 0.f}, y1 = {0.f, 0.f};
#pragma unroll
        for (int j = 0; j < 8; j += 2) {
          const f32x2 t0 = x.v * dd[j] - sa * bb[j], t1 = x.v * dd[j + 1] - sa * bb[j + 1];
          S[j] = S[j] * ww[j] + t0; S[j + 1] = S[j + 1] * ww[j + 1] + t1;
          y0 += S[j] * rr[j]; y1 += S[j + 1] * rr[j + 1];
        }
        ypend = y0 + y1;
      };
      StepIn xa = ldstep(0), xb;
#pragma unroll
      for (int s2 = 0; s2 < 16; s2 += 2) {
        xb = ldstep(s2 + 1);
        dostep(xa, s2);
        if (s2 + 2 < 16) xa = ldstep(s2 + 2);
        dostep(xb, s2 + 1);
      }
      {
        f32x2 yp = ypend;
        yp.x = red8(yp.x); yp.y = red8(yp.y);
        if (sub == 0) *(f32x2*)(yb + 15 * 64 + 2 * rp) = yp;
      }
    }
    if (c + 1 < 144) stage((c + 1) & 1);
    __syncthreads();
    {
      const f32x4 y4 = *(const f32x4*)(yb + ls * 64 + lc);
      *(GL u32x2*)(ald + (size_t)rowof(c * 16 + ls) * 512 + hd * 64 + lc) = pk4(y4);
    }
  }
  __syncthreads();
}

__device__ __forceinline__ void ph_rwkv_post(const Params& p, int e, const bf16_t* zr, const bf16_t* alr, const bf16_t* g, bf16_t* mix) {
  const int tidq = tid_(); const int gdq = gdim_(); const int bidq = bid_(); (void)gdq; (void)bidq;
  OPQ(zr); OPQ(alr); OPQ(g); OPQ(mix);
  const int lane = tidq & 63, c = lane * 8;
  float lw[8], lb[8], rk[8];
#pragma unroll
  for (int i = 0; i < 8; ++i) { lw[i] = p.rw_ln_w[e * 512 + c + i]; lb[i] = p.rw_ln_b[e * 512 + c + i]; rk[i] = p.rw_r_k[e * 512 + c + i]; }
  constexpr int R = 2;
  const int nw = gdq * 4;
  for (int row0 = bidq * 4 + (tidq >> 6); row0 < MT; row0 += nw * R) {
    u32x4 u0[R], u1[R], ur[R], uk[R], uv[R], ug[R];
#pragma unroll
    for (int j = 0; j < R; ++j) {
      const int row = row0 + j * nw;
      if (row < MT) {
        u0[j] = *(const GL u32x4*)(alr + (size_t)row * 512 + c);
        u1[j] = *(const GL u32x4*)(alr + ((size_t)MT + row) * 512 + c);
        ur[j] = *(const GL u32x4*)(zr + (size_t)row * 1536 + c);
        uk[j] = *(const GL u32x4*)(zr + (size_t)row * 1536 + 512 + c);
        uv[j] = *(const GL u32x4*)(zr + (size_t)row * 1536 + 1024 + c);
        ug[j] = *(const GL u32x4*)(g + (size_t)row * 512 + c);
      }
    }
#pragma unroll
    for (int j = 0; j < R; ++j) {
      const int row = row0 + j * nw;
      if (row < MT) {
        float y[8], y1[8], r[8], k[8], v[8], gg[8], o[8];
        unpack8(u0[j], y); unpack8(u1[j], y1); unpack8(ur[j], r); unpack8(uk[j], k); unpack8(uv[j], v); unpack8(ug[j], gg);
        float sm = 0.f, bs = 0.f;
#pragma unroll
        for (int i = 0; i < 8; ++i) { y[i] += y1[i]; sm += y[i]; bs += r[i] * k[i] * rk[i]; }
        sm += __shfl_xor(sm, 1); sm += __shfl_xor(sm, 2); sm += __shfl_xor(sm, 4);
        bs += __shfl_xor(bs, 1); bs += __shfl_xor(bs, 2); bs += __shfl_xor(bs, 4);
        const float mean = sm * (1.f / 64.f);
        float vs = 0.f;
#pragma unroll
        for (int i = 0; i < 8; ++i) { y[i] -= mean; vs += y[i] * y[i]; }
        vs += __shfl_xor(vs, 1); vs += __shfl_xor(vs, 2); vs += __shfl_xor(vs, 4);
        const float rstd = rsqrtf(vs * (1.f / 64.f) + 64e-5f);
#pragma unroll
        for (int i = 0; i < 8; ++i) o[i] = (y[i] * rstd * lw[i] + lb[i] + bs * v[i]) * gg[i];
        *(GL u32x4*)(mix + (size_t)row * 1024 + 512 + c) = pack8(o);
      }
    }
  }
}

__device__ __forceinline__ void ph_conv(const Params& p, int o, const bf16_t* zo, bf16_t* uc) {
  const int tidq = tid_(); const int gdq = gdim_(); const int bidq = bid_(); (void)gdq; (void)bidq;
  OPQ(zo); OPQ(uc);
  const int lane = tidq & 63, c = lane * 8;
  float cw[4][8], cb[8];
#pragma unroll
  for (int j = 0; j < 4; ++j)
#pragma unroll
    for (int i = 0; i < 8; ++i) cw[j][i] = p.lru_conv_w[(o * 4 + j) * 512 + c + i];
#pragma unroll
  for (int i = 0; i < 8; ++i) cb[i] = p.lru_conv_b[o * 512 + c + i];
  constexpr int R = 2;
  const int nw = gdq * 4;
  for (int row0 = bidq * 4 + (tidq >> 6); row0 < MT; row0 += nw * R) {
    u32x4 ux[R][4];
#pragma unroll
    for (int r = 0; r < R; ++r) {
      const int row = row0 + r * nw;
      if (row < MT) {
        int t, len;
        if (row < ML) { t = row & 2047; len = 2048; } else { t = (row - ML) & 255; len = 256; }
#pragma unroll
        for (int j = 0; j < 4; ++j) {
          const int tt = t - 1 + j;
          ux[r][j] = (u32x4){0u, 0u, 0u, 0u};
          if (tt >= 0 && tt < len) ux[r][j] = *(const GL u32x4*)(zo + (size_t)(row - 1 + j) * 2560 + c);
        }
      }
    }
#pragma unroll
    for (int r = 0; r < R; ++r) {
      const int row = row0 + r * nw;
      if (row < MT) {
        float acc[8];
#pragma unroll
        for (int i = 0; i < 8; ++i) acc[i] = cb[i];
#pragma unroll
        for (int j = 0; j < 4; ++j) {
          float x[8];
          unpack8(ux[r][j], x);
#pragma unroll
          for (int i = 0; i < 8; ++i) acc[i] += cw[j][i] * x[i];
        }
        *(GL u32x4*)(uc + (size_t)row * 512 + c) = pack8(acc);
      }
    }
  }
}

__device__ __forceinline__ void lru_item(const Params& p, int o, int item, const bf16_t* uc, const bf16_t* gates, bf16_t* hd, char* smem) {
  const int tidq = tid_(); const int gdq = gdim_(); const int bidq = bid_(); (void)gdq; (void)bidq;
  OPQ(uc); OPQ(gates); OPQ(hd);
  const int z = item >> 7, b = (item >> 3) & 15, cgp = item & 7;
  const int tid = tidq, c = tid & 63, seg = tid >> 6, ch = cgp * 64 + c;
  bf16_t* st = (bf16_t*)smem + seg * 6144;
  float* segP = (float*)(smem + 49152); float* segH = segP + 256;
  const float lam = p.lru_lambda[(o * 2 + z) * 512 + ch];
  const float kc = -8.f * log1pf(expf(-lam));
  float carry = 0.f;
  __syncthreads();
  for (int sc = 0; sc < 9; ++sc) {
    const int g0 = sc * 256 + seg * 64;
    int rbase; const int rstep = z ? -1 : 1;
    if (sc == 0) rbase = ML + b * 256 + (z ? 255 - g0 : g0);
    else { const int gl = g0 - 256; rbase = b * 2048 + (z ? 2047 - gl : gl); }
    float P = 1.f, H = 0.f, hin = 0.f;
#pragma unroll 1
    for (int pass = 0; pass < 2; ++pass) {
      if (pass == 1) H = hin;
#pragma unroll 1
      for (int half = 0; half < 2; ++half) {
        u32x4 lr[4], li[4], lu[4];
#pragma unroll
        for (int j = 0; j < 4; ++j) {
          const int q = c + 64 * j, stp = q >> 3, part = q & 7;
          const size_t row = (size_t)(rbase + rstep * (half * 32 + stp));
          const bf16_t* gp = gates + row * 2048 + z * 1024 + cgp * 64 + part * 8;
          lr[j] = *(const GL u32x4*)gp; li[j] = *(const GL u32x4*)(gp + 512);
          lu[j] = *(const GL u32x4*)(uc + row * 512 + cgp * 64 + part * 8);
        }
        __syncthreads();
#pragma unroll
        for (int j = 0; j < 4; ++j) {
          const int q = c + 64 * j;
          *(u32x4*)(st + q * 8) = lr[j]; *(u32x4*)(st + 2048 + q * 8) = li[j]; *(u32x4*)(st + 4096 + q * 8) = lu[j];
        }
        __syncthreads();
#pragma unroll 8
        for (int i = 0; i < 32; ++i) {
          const float rg = bf2f(st[i * 64 + c]), ig = bf2f(st[2048 + i * 64 + c]), u = bf2f(st[4096 + i * 64 + c]);
          const float la = kc * rg, a = __expf(la);
          const float t2 = 2.f * la;
          const float om = (t2 > -0.02f) ? -t2 * (1.f + t2 * (0.5f + t2 * 0.16666667f)) : 1.f - a * a;
          const float x = __builtin_amdgcn_sqrtf(fmaxf(om, 0.f)) * ig * u;
          H = a * H + x;
          if (pass == 0) P *= a;
          else hd[((size_t)z * MT + (size_t)(rbase + rstep * (half * 32 + i))) * 512 + ch] = f2bf(H);
        }
      }
      if (pass == 0) {
        segP[seg * 64 + c] = P; segH[seg * 64 + c] = H;
        __syncthreads();
        float h = carry;
#pragma unroll
        for (int s2 = 0; s2 < 4; ++s2) { if (s2 == seg) hin = h; h = segP[s2 * 64 + c] * h + segH[s2 * 64 + c]; }
        carry = h;
      }
    }
    __syncthreads();
  }
}
__device__ __forceinline__ void ph_lru_post(const bf16_t* hd, bf16_t* zo) {
  const int tidq = tid_(); const int gdq = gdim_(); const int bidq = bid_(); (void)gdq; (void)bidq;
  OPQ(hd); OPQ(zo);
  const int lane = tidq & 63, c = lane * 8;
  constexpr int R = 4;
  const int nw = gdq * 4;
  for (int row0 = bidq * 4 + (tidq >> 6); row0 < MT; row0 += nw * R) {
    u32x4 ua[R], ub[R], ug[R];
#pragma unroll
    for (int j = 0; j < R; ++j) {
      const int row = row0 + j * nw;
      if (row < MT) {
        ua[j] = *(const GL u32x4*)(hd + (size_t)row * 512 + c);
        ub[j] = *(const GL u32x4*)(hd + ((size_t)MT + row) * 512 + c);
        ug[j] = *(const GL u32x4*)(zo + (size_t)row * 2560 + 512 + c);
      }
    }
#pragma unroll
    for (int j = 0; j < R; ++j) {
      const int row = row0 + j * nw;
      if (row < MT) {
        float a[8], b2[8], g[8], o[8];
        unpack8(ua[j], a); unpack8(ub[j], b2); unpack8(ug[j], g);
#pragma unroll
        for (int i = 0; i < 8; ++i) {
          const float x = g[i];
          const float ge = 0.5f * x * (1.f + tanhf(0.7978845608028654f * (x + 0.044715f * x * x * x)));
          o[i] = (a[i] + b2[i]) * ge;
        }
        *(GL u32x4*)(zo + (size_t)row * 2560 + c) = pack8(o);
      }
    }
  }
}

__device__ __forceinline__ void attn_item(const Params& p, int o, int item, int local, bf16_t* zo, char* smem) {
  const int tidq = tid_(); const int gdq = gdim_(); const int bidq = bid_(); (void)gdq; (void)bidq;
  OPQ(zo);
  const int tid = tidq, lane = tid & 63, w = tid >> 6, fr = lane & 15, fq = lane >> 4;
  constexpr int VS = 524;
  bf16_t* Vt = (bf16_t*)smem;
  float* rpbs = (float*)(smem + 67072);
  int h, b, r = 0, r0 = 0, qrow, qcol = 0, band0 = 0;
  if (local) {
    h = item & 7; r = (item >> 3) & 31; b = item >> 8;
    r0 = min(max(r - 4, 0), 24);
    qcol = w * 16 + fr;
    band0 = min(max(w * 16 - 8, 0), 32);
    qrow = b * 2048 + r * 64 + qcol;
  } else {
    h = item & 7; b = (item >> 3) & 15;
    const int g4 = item >> 7;
    qrow = ML + b * 256 + g4 * 64 + w * 16 + fr;
  }
  const bf16_t* qp = zo + (size_t)qrow * 2560 + 1024 + h * 64;
  const bf16x8 qf0 = *(const GL bf16x8*)(qp + fq * 8), qf1 = *(const GL bf16x8*)(qp + 32 + fq * 8);
  float m1 = -1e30f, lsum = 0.f;
  f32x4 O[4];
#pragma unroll
  for (int i = 0; i < 4; ++i) O[i] = (f32x4){0.f, 0.f, 0.f, 0.f};
  __syncthreads();
  if (local) {
#pragma unroll 4
    for (int i = 0; i < 16; ++i) {
      const int tok = lane + 64 * (i & 7), e8 = (w * 2 + (i >> 3)) * 8;
      const int row = b * 2048 + (r0 + (tok >> 6)) * 64 + (tok & 63);
      const u32x4 v = *(const GL u32x4*)(zo + (size_t)row * 2560 + 2048 + h * 64 + e8);
      const unsigned uu[4] = {v.x, v.y, v.z, v.w};
#pragma unroll
      for (int j = 0; j < 4; ++j) { Vt[(e8 + 2 * j) * VS + tok] = (bf16_t)(uu[j] & 0xffffu); Vt[(e8 + 2 * j + 1) * VS + tok] = (bf16_t)(uu[j] >> 16); }
    }
    for (int i = tid; i < 465; i += 256) rpbs[i] = p.na_rpb[(size_t)(o * 8 + h) * 465 + i];
    __syncthreads();
    f32x4 sc[16];
    const int win0 = min(max(qcol - 8, 0), 48);
    float mx = -1e30f;
#pragma unroll
    for (int ni = 0; ni < 16; ++ni) {
      const int kr = ni >> 1, j0 = (ni & 1) * 16;
      const bf16_t* kp = zo + (size_t)(b * 2048 + (r0 + kr) * 64 + band0 + j0 + fr) * 2560 + 1536 + h * 64;
      const bf16x8 k0 = *(const GL bf16x8*)(kp + fq * 8), k1 = *(const GL bf16x8*)(kp + 32 + fq * 8);
      f32x4 s = {0.f, 0.f, 0.f, 0.f};
      s = mfma16(k0, qf0, s); s = mfma16(k1, qf1, s);
      const int drow = r0 + kr - r + 7;
#pragma unroll
      for (int j = 0; j < 4; ++j) {
        const int kcol = band0 + j0 + fq * 4 + j;
        const int rel = kcol - win0;
        const int dcol = min(max(kcol - qcol + 15, 0), 30);
        const float val = (rel >= 0 && rel < 16) ? s[j] * 0.125f + rpbs[drow * 31 + dcol] : -1e30f;
        s[j] = val; mx = fmaxf(mx, val);
      }
      sc[ni] = s;
    }
    mx = fmaxf(mx, __shfl_xor(mx, 16)); mx = fmaxf(mx, __shfl_xor(mx, 32));
    m1 = mx;
#pragma unroll
    for (int a = 0; a < 8; ++a) {
      f32x4 p0, p1;
#pragma unroll
      for (int j = 0; j < 4; ++j) { p0[j] = __expf(sc[2 * a][j] - m1); p1[j] = __expf(sc[2 * a + 1][j] - m1); lsum += p0[j] + p1[j]; }
      const u32x2 a0 = pk4(p0), a1 = pk4(p1);
      const u32x4 pu = {a0.x, a0.y, a1.x, a1.y};
      const bf16x8 pf = *(const bf16x8*)&pu;
#pragma unroll
      for (int ne = 0; ne < 4; ++ne) {
        const bf16_t* vp = Vt + (ne * 16 + fr) * VS + a * 64 + band0 + fq * 4;
        const u32x2 lo = *(const u32x2*)vp, hi = *(const u32x2*)(vp + 16);
        const u32x4 vu = {lo.x, lo.y, hi.x, hi.y};
        O[ne] = mfma16(*(const bf16x8*)&vu, pf, O[ne]);
      }
    }
    __syncthreads();
  }
#pragma unroll 4
  for (int i = 0; i < 8; ++i) {
    const int tok = lane + 64 * (i & 3), e8 = (w * 2 + (i >> 2)) * 8;
    const u32x4 v = *(const GL u32x4*)(zo + (size_t)(ML + b * 256 + tok) * 2560 + 2048 + h * 64 + e8);
    const unsigned uu[4] = {v.x, v.y, v.z, v.w};
#pragma unroll
    for (int j = 0; j < 4; ++j) { Vt[(e8 + 2 * j) * VS + tok] = (bf16_t)(uu[j] & 0xffffu); Vt[(e8 + 2 * j + 1) * VS + tok] = (bf16_t)(uu[j] >> 16); }
  }
  __syncthreads();
  {
    f32x4 sc[16];
    float mx = -1e30f;
#pragma unroll
    for (int ni = 0; ni < 16; ++ni) {
      const bf16_t* kp = zo + (size_t)(ML + b * 256 + ni * 16 + fr) * 2560 + 1536 + h * 64;
      const bf16x8 k0 = *(const GL bf16x8*)(kp + fq * 8), k1 = *(const GL bf16x8*)(kp + 32 + fq * 8);
      f32x4 s = {0.f, 0.f, 0.f, 0.f};
      s = mfma16(k0, qf0, s); s = mfma16(k1, qf1, s);
#pragma unroll
      for (int j = 0; j < 4; ++j) { s[j] *= 0.125f; mx = fmaxf(mx, s[j]); }
      sc[ni] = s;
    }
    mx = fmaxf(mx, __shfl_xor(mx, 16)); mx = fmaxf(mx, __shfl_xor(mx, 32));
    const float m2 = fmaxf(m1, mx);
    const float alpha = __expf(m1 - m2);
    lsum *= alpha;
#pragma unroll
    for (int ne = 0; ne < 4; ++ne) O[ne] *= alpha;
#pragma unroll
    for (int a = 0; a < 8; ++a) {
      f32x4 p0, p1;
#pragma unroll
      for (int j = 0; j < 4; ++j) { p0[j] = __expf(sc[2 * a][j] - m2); p1[j] = __expf(sc[2 * a + 1][j] - m2); lsum += p0[j] + p1[j]; }
      const u32x2 a0 = pk4(p0), a1 = pk4(p1);
      const u32x4 pu = {a0.x, a0.y, a1.x, a1.y};
      const bf16x8 pf = *(const bf16x8*)&pu;
#pragma unroll
      for (int ne = 0; ne < 4; ++ne) {
        const bf16_t* vp = Vt + (ne * 16 + fr) * VS + a * 32 + fq * 4;
        const u32x2 lo = *(const u32x2*)vp, hi = *(const u32x2*)(vp + 16);
        const u32x4 vu = {lo.x, lo.y, hi.x, hi.y};
        O[ne] = mfma16(*(const bf16x8*)&vu, pf, O[ne]);
      }
    }
  }
  lsum += __shfl_xor(lsum, 16); lsum += __shfl_xor(lsum, 32);
  const float inv = 1.f / lsum;
  bf16_t* op = zo + (size_t)qrow * 2560 + 1024 + h * 64 + fq * 4;
#pragma unroll
  for (int ne = 0; ne < 4; ++ne) *(GL u32x2*)(op + ne * 16) = pk4(O[ne] * inv);
  __syncthreads();
}


#define XB_TMO      128
#define XB_XCNT(j)  (256  + 64 * (j))
#define XB_XSUB(j)  (1280 + 64 * (j))
#define XB_XGEN(j)  (2304 + 64 * (j))
#define XB_TOP      3328
#define XB_TOPGEN   3392
#define XCD_BAR_WORDS 3456
#define XB_SPIN_CAP (1u << 18)
#define LAS __attribute__((address_space(3)))
__device__ __forceinline__ unsigned xb_ld(unsigned* p)              { return __hip_atomic_load(p, __ATOMIC_RELAXED, __HIP_MEMORY_SCOPE_AGENT); }
__device__ __forceinline__ unsigned xb_add(unsigned* p, unsigned v) { return __hip_atomic_fetch_add(p, v, __ATOMIC_RELAXED, __HIP_MEMORY_SCOPE_AGENT); }
__device__ __forceinline__ unsigned xb_xcc_id() { return (unsigned)__builtin_amdgcn_s_getreg((3 << 11) | 20) & 0xFu; }
#define XB_SPIN(cond, bar) do { unsigned _sp = 0; while (cond) { __builtin_amdgcn_s_sleep(1); \
    if ((++_sp & 255u) == 0u) { if (xb_ld(&(bar)[XB_TMO])) break; if (_sp > XB_SPIN_CAP) { atomicAdd(&(bar)[XB_TMO], 1u); break; } } } } while (0)
struct XcdBarrier { unsigned* bar; unsigned x; volatile LAS unsigned* st; };
__device__ __forceinline__ XcdBarrier xcd_barrier_post(unsigned* bar, volatile LAS unsigned* st) {
  XcdBarrier b; b.bar = bar; b.x = xb_xcc_id(); b.st = st;
  if (threadIdx.x == 0) (void)xb_add(&bar[XB_XCNT(b.x)], 1u);
  return b;
}
__device__ __forceinline__ void xcd_barrier_complete(unsigned* bar, unsigned x, unsigned& nloc, unsigned& nx) {
  const unsigned G = gridDim.x * gridDim.y * gridDim.z;
  unsigned sum, cnt, mine, sp = 0u;
  for (;;) {
    sum = 0u; cnt = 0u; mine = 0u;
#pragma unroll
    for (unsigned j = 0; j < 16; ++j) { const unsigned c = xb_ld(&bar[XB_XCNT(j)]); sum += c; cnt += (c > 0u) ? 1u : 0u; mine = (j == x) ? c : mine; }
    if (sum == G) break;
    __builtin_amdgcn_s_sleep(1);
    if ((++sp & 255u) == 0u) { if (xb_ld(&bar[XB_TMO])) break; if (sp > XB_SPIN_CAP) { atomicAdd(&bar[XB_TMO], 1u); break; } }
  }
  nloc = mine > 0u ? mine : 1u; nx = cnt > 0u ? cnt : 1u;
}
__device__ __forceinline__ void xcd_barrier(const XcdBarrier& b) {
  asm volatile("s_waitcnt vmcnt(0)" ::: "memory");
  __syncthreads();
  if (threadIdx.x == 0) {
    unsigned* bar = b.bar;
    __builtin_amdgcn_s_waitcnt(0);
    unsigned nloc = b.st[0], nx = b.st[1];
    if (nloc == 0u) { xcd_barrier_complete(bar, b.x, nloc, nx); b.st[0] = nloc; b.st[1] = nx; }
    const unsigned old = xb_add(&bar[XB_XSUB(b.x)], 1u);
    const unsigned gen = old / nloc;
    if (old + 1u == (gen + 1u) * nloc) {
      __builtin_amdgcn_fence(__ATOMIC_RELEASE, "agent");
      asm volatile("s_waitcnt vmcnt(0)" ::: "memory");
      const unsigned og = xb_add(&bar[XB_TOP], 1u);
      const unsigned tg = og / nx;
      if (og + 1u == (tg + 1u) * nx) xb_add(&bar[XB_TOPGEN], 1u);
      else XB_SPIN(xb_ld(&bar[XB_TOPGEN]) == tg, bar);
      __builtin_amdgcn_fence(__ATOMIC_ACQUIRE, "agent");
      xb_add(&bar[XB_XGEN(b.x)], 1u);
      asm volatile("s_waitcnt vmcnt(0)" ::: "memory");
    } else {
      XB_SPIN(xb_ld(&bar[XB_XGEN(b.x)]) == gen, bar);
      __builtin_amdgcn_fence(__ATOMIC_ACQUIRE, "agent");
      asm volatile("s_waitcnt vmcnt(0)" ::: "memory");
    }
  }
  __syncthreads();
}
#define WSN (opq_(*(char* const volatile*)&p.ws))
#define OUTN (opq_(*(float* const volatile*)&p.out))
#define XN_ (opq_(*(const float* const volatile*)&p.x))
#define CTXN_ (opq_(*(const float* const volatile*)&p.ctx))
#define B_mod ((float*)(WSN + OFF_MOD))
#define B_gates ((float*)(WSN + OFF_GATES))
#define B_WTIN ((const bf16_t*)(WSN + OFF_WTIN))
#define B_WTOUT ((const bf16_t*)(WSN + OFF_WTOUT))
#define B_WT1 ((const bf16_t*)(WSN + OFF_WT1))
#define B_WT2 ((const bf16_t*)(WSN + OFF_WT2))
#define B_xn ((bf16_t*)(WSN + OFF_ARENA))
#define B_zm ((bf16_t*)(WSN + OFF_ARENA + 2 * SU))
#define B_zw ((bf16_t*)(WSN + OFF_ARENA + 6 * SU))
#define B_mix ((bf16_t*)(WSN + OFF_ARENA + 9 * SU + 3 * (SU / 4)))
#define B_hm ((bf16_t*)(WSN + OFF_ARENA))
#define B_zr ((bf16_t*)(WSN + OFF_ARENA))
#define B_alin ((bf16_t*)(WSN + OFF_ARENA + 3 * SU))
#define B_ldp ((_Float16*)(WSN + OFF_ARENA + 3 * SU + 3 * (SU / 4)))
#define B_alr ((bf16_t*)(WSN + OFF_ARENA + 5 * SU + 3 * (SU / 4)))
#define B_gg ((bf16_t*)(WSN + OFF_ARENA + 7 * SU + 3 * (SU / 4)))
#define B_zo ((bf16_t*)(WSN + OFF_ARENA + 2 * SU))
#define B_uc ((bf16_t*)(WSN + OFF_ARENA + 7 * SU))
#define B_lg ((bf16_t*)(WSN + OFF_ARENA + 8 * SU))
#define B_hd ((bf16_t*)(WSN + OFF_ARENA))
#define B_uh ((bf16_t*)(WSN + OFF_ARENA + 2 * SU))
#define B_AR (WSN + OFF_ARENA)
#define B_ws (WSN)
__global__ void __launch_bounds__(256, 2) mega(Params pk) {
  cg::grid_group grid = cg::this_grid();
  if (blockDim.x == 7) grid.sync();
  __shared__ __attribute__((aligned(16))) char smem[73728];
  __shared__ Params sp_;
  __shared__ uint4 xb_words;
  if (threadIdx.x == 0) { sp_ = pk; xb_words = make_uint4(0u, 0u, 0u, 0u); }
  __syncthreads();
  const Params& p = sp_;
  XcdBarrier xb = xcd_barrier_post((unsigned*)(pk.ws + OFF_BAR), (volatile LAS unsigned*)&xb_words);
  const int NOJ = 1 << 30;

  if (blockIdx.x == 0 && threadIdx.x < 64) ((unsigned*)WSN)[threadIdx.x] = 0u;
  ph_prologue(p, smem);
  GSYNC();
  for (int l = 0; l < 4; ++l) {
    const bool last = (l == 3);
    const int Mrows = last ? ML : MT;
    ph_convert(p, l, smem);
    ph_norm(p, l, 0, MT, B_xn, l == 0);
    GSYNC();
    if (SKIP_EVEN && (l & 1) == 0) {
    } else if ((l & 1) == 0) {
      const int e = l >> 1;
      if (EVMASK & 1) gemm_phase(B_xn, 1024, NOJ, 0, B_WTIN, 1024, MT, 3984, 1024, EpiInEven{B_zm, B_zw, B_gates}, smem);
      GSYNC();
      if (EVMASK & 2) ph_rope(p, B_zm);
      GSYNC();
      if (!SKIP_MLSTM) for (int it = blockIdx.x; it < 256; it += gridDim.x) mlstm_item(p, e, it, B_zm, B_gates, B_hm, smem);
      GSYNC();
      if (EVMASK & 4) ph_mlstm_post(p, e, B_zm, B_hm, B_mix);
      GSYNC();
      if (EVMASK & 8) ph_rwkv_prep(p, e, B_zw, B_zr, B_alin);
      GSYNC();
      gemm_phase_t<4>(B_alin, 384, NOJ, 0, (const bf16_t*)(B_ws + OFF_WUP), 64, MT, 1024, 64, EpiLdV{B_ldp, p.rw_w0 + e * 1024}, smem, 512);
      for (int d = 0; d < 2; ++d)
        gemm_phase(B_alin + 128 + d * 64, 384, NOJ, 0, (const bf16_t*)(B_ws + OFF_AUP) + d * 512 * 64, 64, MT, 512, 64,
                   EpiAlr{B_alr + (size_t)d * MT * 512, p.rw_a0 + (e * 2 + d) * 512}, smem);
      if ((EVMASK & 16)) gemm_phase(B_alin + 256, 384, NOJ, 0, (const bf16_t*)(B_ws + OFF_GUP), 128, MT, 512, 128, EpiStore{B_gg, 512}, smem);
      GSYNC();
      if (!SKIP_RWKV) for (int it = blockIdx.x; it < 256; it += gridDim.x) rwkv_item(p, e, it, B_zr, B_ldp, B_alr, smem);
      GSYNC();
      if (EVMASK & 32) ph_rwkv_post(p, e, B_zr, B_alr, B_gg, B_mix);
      GSYNC();
      if (EVMASK & 64) gemm_phase(B_mix, 1024, NOJ, 0, B_WTOUT, 1024, Mrows, 1024, 1024, EpiResid{OUTN, (float*)(B_ws + OFF_HCTX), B_mod + (size_t)l * 17 * 6144 + 2048, (l == 0 ? XN_ : (const float*)OUTN), (l == 0 ? CTXN_ : (const float*)(B_ws + OFF_HCTX))}, smem);
      GSYNC();
    } else if (!SKIP_ODD) {
      const int o = l >> 1;
      gemm_phase(B_xn, 1024, NOJ, 0, B_WTIN, 1024, MT, 2560, 1024, EpiStore{B_zo, 2560}, smem);
      GSYNC();
      ph_conv(p, o, B_zo, B_uc);
      GSYNC();
      gemm_phase_t<4>(B_uc, 512, NOJ, 0, (const bf16_t*)(B_ws + OFF_GWT), 64, MT, 2048, 64, EpiGates{B_lg, p.lru_gate_b + o * 2048}, smem, 256);
      GSYNC();
      {
        const int n_lru = 256, n_na = 4096, n_ca = last ? 0 : 512;
        __shared__ int s_it;
        unsigned* ctr = (unsigned*)WSN + 16 * o;
        for (;;) {
          __syncthreads();
          if (threadIdx.x == 0) s_it = (int)atomicAdd(ctr, 1u);
          __syncthreads();
          const int it = s_it;
          if (it >= n_lru + n_na + n_ca) break;
          if (it < n_lru) lru_item(p, o, it, B_uc, B_lg, B_hd, smem);
          else if (it < n_lru + n_na) attn_item(p, o, it - n_lru, 1, B_zo, smem);
          else attn_item(p, o, it - n_lru - n_na, 0, B_zo, smem);
        }
      }
      GSYNC();
      ph_lru_post(B_hd, B_zo);
      GSYNC();
      gemm_phase(B_zo, 2560, 512, 512, B_WTOUT, 1024, Mrows, 1024, 1024, EpiResid{OUTN, (float*)(B_ws + OFF_HCTX), B_mod + (size_t)l * 17 * 6144 + 2048, (l == 0 ? XN_ : (const float*)OUTN), (l == 0 ? CTXN_ : (const float*)(B_ws + OFF_HCTX))}, smem);
      GSYNC();
    }
    ph_norm(p, l, 1, Mrows, B_xn);
    GSYNC();
    gemm_phase(B_xn, 1024, NOJ, 0, B_WT1, 1024, Mrows, 4096, 1024, EpiMlp1{B_uh}, smem);
    GSYNC();
    gemm_phase(B_uh, 4096, NOJ, 0, B_WT2, 4096, Mrows, 1024, 4096, EpiResid{OUTN, (float*)(B_ws + OFF_HCTX), B_mod + (size_t)l * 17 * 6144 + 5120, (const float*)OUTN, (const float*)(B_ws + OFF_HCTX)}, smem);
    GSYNC();
  }
  ph_final_norm(p);
}

extern "C" void kernel_launch(void* const* d_in, const int* in_sizes, int n_in, void* d_out, int out_size,
                              void* d_ws, size_t ws_size, hipStream_t stream) {
  static int grid_blocks = 0;
  if (!grid_blocks) {
    int dev = 0, cus = 0, per_cu = 0;
    (void)hipGetDevice(&dev);
    (void)hipDeviceGetAttribute(&cus, hipDeviceAttributeMultiprocessorCount, dev);
    (void)hipOccupancyMaxActiveBlocksPerMultiprocessor(&per_cu, mega, 256, 0);
    if (per_cu > 2) per_cu = 2;
    if (per_cu < 1) per_cu = 1;
    grid_blocks = cus * per_cu;
  }
  Params p{};
  const float** pp = (const float**)&p;
  for (int i = 0; i < 31; ++i) pp[i] = (const float*)d_in[i];
  p.out = (float*)d_out;
  p.ws = (char*)d_ws;
  (void)hipMemsetAsync((char*)d_ws + OFF_BAR, 0, 16384, stream);
  void* args[] = {&p};
  hipError_t e = hipLaunchCooperativeKernel((void*)mega, dim3(grid_blocks), dim3(256), args, 0, stream);
  if (e != hipSuccess) fprintf(stderr, "cooperative launch failed: %s (grid %d)\n", hipGetErrorString(e), grid_blocks);
}
```
